# Optimizing an MI355X kernel written in HIP

```python
import math
import jax, jax.numpy as jnp
from jax import lax
import numpy as np

D_MODEL = 2048
BATCH = 16
SEQ = 256
DEPTH = 4
DEC_BATCH = 2
DEC_SEQ = 4096
PAST_LEN = 256

GRID_W = 64
NA_HEADS = 8
NA_DIM = 128
NA_WIN_R = 8
NA_WIN_C = 16
SG_GROUPS = 4
SG_DIM = 128
SG_CHUNK = 128
DF_HEADS = 4
DF_QK = 64
DF_V = 128
ROPE_THETA = 10000.0
NA_WIDTH = NA_HEADS * NA_DIM
SG_WIDTH = SG_GROUPS * SG_DIM
DF_WIDTH = DF_HEADS * DF_V
MIX_WIDTH = NA_WIDTH + SG_WIDTH + DF_WIDTH
IN_WIDTH = 3 * NA_WIDTH + 2 * SG_WIDTH + 4 * DF_HEADS * DF_QK + DF_WIDTH
PK_HEADS = 8
PK_QDIM = 256
PK_NKEYS = 128
PK_TOPK = 16
PK_EXPERTS = PK_NKEYS * PK_NKEYS
PK_TOKEN_BLOCK = 128
ATTN_BLOCK = 128
DN_ALPHA = (2 * DEPTH) ** 0.25
DN_BETA = (8 * DEPTH) ** -0.25
LN_EPS = 1e-5
RMS_EPS = 1e-6

kernel_name = 'hybrid_natten_sgmlp_diffattn_peer_denoise_step'


def _layernorm(x, g, b):
    xf = x.astype(jnp.float32)
    mu = jnp.mean(xf, -1, keepdims=True)
    var = jnp.mean(jnp.square(xf - mu), -1, keepdims=True)
    return ((xf - mu) * lax.rsqrt(var + LN_EPS) * g.astype(jnp.float32) + b.astype(jnp.float32)).astype(x.dtype)


def _rmsnorm(x, g):
    xf = x.astype(jnp.float32)
    return (xf * lax.rsqrt(jnp.mean(xf * xf, -1, keepdims=True) + RMS_EPS) * g.astype(jnp.float32)).astype(x.dtype)


def _heads(a, n):
    B, T, _ = a.shape
    return a.reshape(B, T, n, -1).transpose(0, 2, 1, 3)


def _merge(o):
    B, H, T, d = o.shape
    return o.transpose(0, 2, 1, 3).reshape(B, T, H * d)


def _project(h, w_in_l):
    widths = [NA_WIDTH] * 3 + [SG_WIDTH] * 2 + [DF_HEADS * DF_QK] * 4 + [DF_WIDTH]
    cuts = np.cumsum(widths)[:-1].tolist()
    return jnp.split(h @ w_in_l, cuts, axis=-1)


def _axial_rope(n_tokens, dim, dtype):
    t = jnp.arange(n_tokens)
    row = (t // GRID_W).astype(jnp.float32)
    col = (t % GRID_W).astype(jnp.float32)
    n_freq = dim // 4
    inv = 1.0 / (ROPE_THETA ** (jnp.arange(n_freq, dtype=jnp.float32) / n_freq))
    ang = jnp.concatenate([row[:, None] * inv, col[:, None] * inv], -1)
    return jnp.cos(ang).astype(dtype), jnp.sin(ang).astype(dtype)


def _apply_rope(x, cos, sin):
    x1, x2 = jnp.split(x, 2, -1)
    return jnp.concatenate([x1 * cos - x2 * sin, x1 * sin + x2 * cos], -1)


def _sweep_queries(fn, qs):
    B, H, T, _ = qs[0].shape
    nb = T // ATTN_BLOCK
    blocks = tuple(q.reshape(B, H, nb, ATTN_BLOCK, q.shape[-1]).transpose(2, 0, 1, 3, 4) for q in qs)
    out = lax.map(lambda blk: fn(*blk), blocks)
    return out.transpose(1, 2, 0, 3, 4).reshape(B, H, T, out.shape[-1])


def _softmax_attn(q, k, v):
    scale = q.shape[-1] ** -0.5
    def blk(qb):
        s = jnp.einsum('bhqd,bhkd->bhqk', qb, k).astype(jnp.float32) * scale
        p = jax.nn.softmax(s, -1).astype(v.dtype)
        return jnp.einsum('bhqk,bhkd->bhqd', p, v)
    return _sweep_queries(blk, (q,))


def _diff_lambda(lp, lam_init):
    lf = lp.astype(jnp.float32)
    return jnp.exp(jnp.sum(lf[0] * lf[1])) - jnp.exp(jnp.sum(lf[2] * lf[3])) + lam_init


def _diff_attn(q1, q2, k1, k2, v, lam):
    scale = DF_QK ** -0.5
    def blk(a, b):
        p1 = jax.nn.softmax(jnp.einsum('bhqd,bhkd->bhqk', a, k1).astype(jnp.float32) * scale, -1)
        p2 = jax.nn.softmax(jnp.einsum('bhqd,bhkd->bhqk', b, k2).astype(jnp.float32) * scale, -1)
        return jnp.einsum('bhqk,bhkd->bhqd', (p1 - lam * p2).astype(v.dtype), v)
    return _sweep_queries(blk, (q1, q2))


def _neighbourhood_attn(q, k, v, k_ctx, v_ctx, rpb):
    B, H, T, d = q.shape
    rows = T // GRID_W
    wr = min(NA_WIN_R, rows)
    wc = NA_WIN_C
    scale = d ** -0.5
    qg = q.reshape(B, H, rows, GRID_W, d)
    kg = k.reshape(B, H, rows, GRID_W, d)
    vg = v.reshape(B, H, rows, GRID_W, d)
    cols = jnp.arange(GRID_W)
    col_start = jnp.clip(cols - wc // 2, 0, GRID_W - wc)
    col_idx = col_start[:, None] + jnp.arange(wc)[None, :]
    dc = col_idx - cols[:, None] + (NA_WIN_C - 1)

    def row_step(r):
        r0 = jnp.clip(r - wr // 2, 0, rows - wr)
        kb = lax.dynamic_slice_in_dim(kg, r0, wr, axis=2)
        vb = lax.dynamic_slice_in_dim(vg, r0, wr, axis=2)
        kw = jnp.take(kb, col_idx, axis=3)
        vw = jnp.take(vb, col_idx, axis=3)
        qr = lax.dynamic_index_in_dim(qg, r, axis=2, keepdims=False)
        dr = r0 + jnp.arange(wr) - r + (NA_WIN_R - 1)
        bias = rpb[:, dr[:, None, None], dc[None, :, :]].transpose(0, 2, 1, 3)
        s_loc = jnp.einsum('bhqd,bhrqjd->bhqrj', qr, kw).astype(jnp.float32) * scale + bias[None].astype(jnp.float32)
        s_ctx = jnp.einsum('bhqd,bhkd->bhqk', qr, k_ctx).astype(jnp.float32) * scale
        s = jnp.concatenate([s_loc.reshape(B, H, GRID_W, wr * wc), s_ctx], -1)
        p = jax.nn.softmax(s, -1).astype(v.dtype)
        p_loc = p[..., :wr * wc].reshape(B, H, GRID_W, wr, wc)
        p_ctx = p[..., wr * wc:]
        return jnp.einsum('bhqrj,bhrqjd->bhqd', p_loc, vw) + jnp.einsum('bhqk,bhkd->bhqd', p_ctx, v_ctx)

    out = lax.map(row_step, jnp.arange(rows))
    return out.transpose(1, 2, 0, 3, 4).reshape(B, H, T, d)


def _spatial_gate(u, v, ln_g, ln_b, w_s, b_s):
    B, T, _ = u.shape
    n = T // SG_CHUNK
    vn = _layernorm(v, ln_g, ln_b).reshape(B, n, SG_CHUNK, SG_GROUPS, SG_DIM)
    mixed = jnp.einsum('gpq,bnqgc->bnpgc', w_s, vn) + b_s.T[None, None, :, :, None]
    return u * mixed.reshape(B, T, SG_WIDTH)


def _mix_out(oa, ob, oc, subln_g, lam_init, w_out_l):
    oc = _rmsnorm(oc, subln_g) * (1.0 - lam_init)
    return jnp.concatenate([_merge(oa), ob, _merge(oc)], -1) @ w_out_l


def _mix_context(h, w_in_l, sg_ln_g_l, sg_ln_b_l, sg_w_l, sg_b_l, lam, subln_g, lam_init, w_out_l):
    qa, ka, va, u, v, q1, q2, k1, k2, vc = _project(h, w_in_l)
    qa, ka, va = (_heads(t, NA_HEADS) for t in (qa, ka, va))
    q1, q2, k1, k2, vc = (_heads(t, DF_HEADS) for t in (q1, q2, k1, k2, vc))
    oa = _softmax_attn(qa, ka, va)
    ob = _spatial_gate(u, v, sg_ln_g_l, sg_ln_b_l, sg_w_l, sg_b_l)
    oc = _diff_attn(q1, q2, k1, k2, vc, lam)
    return _mix_out(oa, ob, oc, subln_g, lam_init, w_out_l), (ka, va, k1, k2, vc)


def _mix_latent(h, caches, rpb, w_in_l, sg_ln_g_l, sg_ln_b_l, sg_w_l, sg_b_l, lam, subln_g, lam_init, w_out_l):
    ka_c, va_c, k1_c, k2_c, v_c = caches
    qa, ka, va, u, v, q1, q2, k1, k2, vc = _project(h, w_in_l)
    qa, ka, va = (_heads(t, NA_HEADS) for t in (qa, ka, va))
    cos, sin = _axial_rope(h.shape[1], DF_QK, h.dtype)
    q1, q2, k1, k2 = (_apply_rope(_heads(t, DF_HEADS), cos, sin) for t in (q1, q2, k1, k2))
    vc = _heads(vc, DF_HEADS)
    oa = _neighbourhood_attn(qa, ka, va, ka_c, va_c, rpb)
    ob = _spatial_gate(u, v, sg_ln_g_l, sg_ln_b_l, sg_w_l, sg_b_l)
    oc = _diff_attn(q1, q2, jnp.concatenate([k1, k1_c], 2), jnp.concatenate([k2, k2_c], 2),
                    jnp.concatenate([vc, v_c], 2), lam)
    return _mix_out(oa, ob, oc, subln_g, lam_init, w_out_l), ()


def _peer(x, w_q, sub_keys, u_tab, v_tab):
    B, T, D = x.shape
    n = B * T
    xt = x.reshape(n, D)
    q = (xt @ w_q).reshape(n, PK_HEADS, 2, PK_QDIM // 2)
    s = jnp.einsum('nhad,hakd->nhak', q, sub_keys).astype(jnp.float32)
    sv, si = lax.top_k(s, PK_TOPK)
    cand = sv[:, :, 0, :, None] + sv[:, :, 1, None, :]
    cand_idx = si[:, :, 0, :, None] * PK_NKEYS + si[:, :, 1, None, :]
    best, pos = lax.top_k(cand.reshape(n, PK_HEADS, PK_TOPK * PK_TOPK), PK_TOPK)
    idx = jnp.take_along_axis(cand_idx.reshape(n, PK_HEADS, PK_TOPK * PK_TOPK), pos, -1)
    g = jax.nn.softmax(best, -1).astype(x.dtype)
    nb = n // PK_TOKEN_BLOCK
    hk = PK_HEADS * PK_TOPK

    def blk(args):
        xb, ib, gb = args
        ue = jnp.take(u_tab, ib, axis=0)
        act = jax.nn.gelu(jnp.einsum('nkd,nd->nk', ue, xb), approximate=False)
        ve = jnp.take(v_tab, ib, axis=0)
        return jnp.einsum('nk,nkd->nd', gb * act, ve)

    out = lax.map(blk, (xt.reshape(nb, PK_TOKEN_BLOCK, D), idx.reshape(nb, PK_TOKEN_BLOCK, hk),
                        g.reshape(nb, PK_TOKEN_BLOCK, hk)))
    return out.reshape(B, T, D)


def _trunk_layer(x, cond, mix_fn, w_mod_l, b_mod_l, ln_g_l, ln_b_l, peer_w):
    mod = jax.nn.silu(cond) @ w_mod_l + b_mod_l
    sh1, sc1, g1, sh2, sc2, g2 = (m[..., None, :] for m in jnp.split(mod, 6, -1))
    y, ctx_tensors = mix_fn(x * (1 + sc1) + sh1)
    x = _layernorm(DN_ALPHA * x + g1 * y, ln_g_l[0], ln_b_l[0])
    y = _peer(x * (1 + sc2) + sh2, *peer_w)
    x = _layernorm(DN_ALPHA * x + g2 * y, ln_g_l[1], ln_b_l[1])
    return x, ctx_tensors


def setup_inputs(seed: int = 0) -> dict:
    key = jax.random.key(seed)
    ks = jax.random.split(key, 32)
    def nrm(k, shape, s=1.0):
        return jax.random.normal(k, shape, jnp.float32) * s
    L = PAST_LEN
    return {
        'x_prompt': nrm(ks[0], (BATCH, SEQ, D_MODEL)),
        'x_sample': nrm(ks[1], (DEC_BATCH, DEC_SEQ, D_MODEL)),
        'cache_na_k': nrm(ks[2], (DEC_BATCH, DEPTH, NA_HEADS, L, NA_DIM)),
        'cache_na_v': nrm(ks[3], (DEC_BATCH, DEPTH, NA_HEADS, L, NA_DIM)),
        'cache_df_k1': nrm(ks[4], (DEC_BATCH, DEPTH, DF_HEADS, L, DF_QK)),
        'cache_df_k2': nrm(ks[5], (DEC_BATCH, DEPTH, DF_HEADS, L, DF_QK)),
        'cache_df_v': nrm(ks[6], (DEC_BATCH, DEPTH, DF_HEADS, L, DF_V)),
        'c': nrm(ks[7], (DEC_BATCH, D_MODEL)),
        'c_ctx': nrm(ks[8], (D_MODEL,)),
        'w_mod': nrm(ks[9], (DEPTH, D_MODEL, 6 * D_MODEL), 0.5 * D_MODEL ** -0.5),
        'b_mod': nrm(ks[10], (DEPTH, 6 * D_MODEL), 0.02),
        'w_in': nrm(ks[11], (DEPTH, D_MODEL, IN_WIDTH), D_MODEL ** -0.5),
        'na_rpb': nrm(ks[12], (DEPTH, NA_HEADS, 2 * NA_WIN_R - 1, 2 * NA_WIN_C - 1), 0.05),
        'sg_ln_g': 1.0 + nrm(ks[13], (DEPTH, SG_WIDTH), 0.02),
        'sg_ln_b': nrm(ks[14], (DEPTH, SG_WIDTH), 0.02),
        'sg_w': nrm(ks[15], (DEPTH, SG_GROUPS, SG_CHUNK, SG_CHUNK), SG_CHUNK ** -0.5),
        'sg_b': 1.0 + nrm(ks[16], (DEPTH, SG_GROUPS, SG_CHUNK), 0.02),
        'df_lambda': nrm(ks[17], (DEPTH, 4, DF_QK), 0.1),
        'df_subln_g': 1.0 + nrm(ks[18], (DEPTH, DF_V), 0.02),
        'w_out': nrm(ks[19], (DEPTH, MIX_WIDTH, D_MODEL), DN_BETA * MIX_WIDTH ** -0.5),
        'pk_wq': nrm(ks[20], (DEPTH, D_MODEL, PK_HEADS * PK_QDIM), D_MODEL ** -0.5),
        'pk_keys': nrm(ks[21], (DEPTH, PK_HEADS, 2, PK_NKEYS, PK_QDIM // 2), (PK_QDIM // 2) ** -0.5),
        'pk_u': nrm(ks[22], (DEPTH, PK_EXPERTS, D_MODEL), D_MODEL ** -0.5),
        'pk_v': nrm(ks[23], (DEPTH, PK_EXPERTS, D_MODEL), DN_BETA * PK_HEADS ** -0.5),
        'ln_g': 1.0 + nrm(ks[24], (DEPTH, 2, D_MODEL), 0.02),
        'ln_b': nrm(ks[25], (DEPTH, 2, D_MODEL), 0.02),
    }


def reference(x_prompt, x_sample, cache_na_k, cache_na_v, cache_df_k1, cache_df_k2, cache_df_v, c, c_ctx,
              w_mod, b_mod, w_in, na_rpb, sg_ln_g, sg_ln_b, sg_w, sg_b, df_lambda, df_subln_g, w_out,
              pk_wq, pk_keys, pk_u, pk_v, ln_g, ln_b):
    xp, xs = x_prompt, x_sample
    st_na_k, st_na_v, st_df_k1, st_df_k2, st_df_v = [], [], [], [], []
    for l in range(DEPTH):
        lam_init = 0.8 - 0.6 * math.exp(-0.3 * l)
        lam = _diff_lambda(df_lambda[l], lam_init)
        shared = (w_in[l], sg_ln_g[l], sg_ln_b[l], sg_w[l], sg_b[l], lam, df_subln_g[l], lam_init, w_out[l])
        peer_w = (pk_wq[l], pk_keys[l], pk_u[l], pk_v[l])
        xp, (ka, va, k1, k2, vc) = _trunk_layer(xp, c_ctx, lambda h: _mix_context(h, *shared),
                                                w_mod[l], b_mod[l], ln_g[l], ln_b[l], peer_w)
        st_na_k.append(ka)
        st_na_v.append(va)
        st_df_k1.append(k1)
        st_df_k2.append(k2)
        st_df_v.append(vc)
        caches = (cache_na_k[:, l], cache_na_v[:, l], cache_df_k1[:, l], cache_df_k2[:, l], cache_df_v[:, l])
        xs, _ = _trunk_layer(xs, c, lambda h: _mix_latent(h, caches, na_rpb[l], *shared),
                             w_mod[l], b_mod[l], ln_g[l], ln_b[l], peer_w)
    y_prompt = xp
    y_sample = xs
    na_k = jnp.stack(st_na_k, 1)
    na_v = jnp.stack(st_na_v, 1)
    df_k1 = jnp.stack(st_df_k1, 1)
    df_k2 = jnp.stack(st_df_k2, 1)
    df_v = jnp.stack(st_df_v, 1)
    return (y_prompt, y_sample, na_k, na_v, df_k1, df_k2, df_v)
```

```cpp
#include <hip/hip_runtime.h>
#include <stdint.h>
#include <stdio.h>

#ifndef MEGA
#define MEGA 1
#endif
#ifndef PROBE_DUP
#define PROBE_DUP 0
#endif

typedef unsigned short bf16_t;
typedef short bf16x8 __attribute__((ext_vector_type(8)));
typedef float f32x4 __attribute__((ext_vector_type(4)));
typedef float f32x2 __attribute__((ext_vector_type(2)));
typedef unsigned u32x4 __attribute__((ext_vector_type(4)));
typedef unsigned u32x2 __attribute__((ext_vector_type(2)));
typedef __bf16 bf2_t __attribute__((ext_vector_type(2)));
typedef short s16x4 __attribute__((ext_vector_type(4)));
#define LAS __attribute__((address_space(3)))

constexpr int D = 2048;
constexpr int NP = 4096;
constexpr int NS = 8192;
constexpr int NT = NP + NS;
constexpr int INW = 5632;
constexpr int DEPTH = 4;
constexpr int NEXP = 16384;
constexpr float DN_ALPHA = 1.681792830507429f;
constexpr float LOG2E = 1.4426950408889634f;
constexpr int C_QA = 0, C_KA = 1024, C_VA = 2048, C_U = 3072, C_V = 3584, C_Q1 = 4096, C_Q2 = 4352, C_K1 = 4608, C_K2 = 4864, C_VC = 5120;
constexpr size_t O_YP = 0, O_YS = 8388608, O_NAK = 25165824, O_NAV = 41943040, O_K1 = 58720256, O_K2 = 62914560, O_DFV = 67108864;

constexpr int LDS_BYTES = 147456;
constexpr int LDS_BAR_OFF = LDS_BYTES - 64;

constexpr size_t al256c(size_t x) { return (x + 255) & ~(size_t)255; }
constexpr size_t W_BAR = 0;
constexpr size_t W_WINT = W_BAR + al256c(4096 * 4);
constexpr size_t W_WOUTT = W_WINT + al256c((size_t)DEPTH * INW * D * 2);
constexpr size_t W_WQT = W_WOUTT + al256c((size_t)DEPTH * D * D * 2);
constexpr size_t W_KEYSB = W_WQT + al256c((size_t)DEPTH * D * D * 2);
constexpr size_t W_UB = W_KEYSB + al256c((size_t)1048576 * 2);
constexpr int ROW4 = D / 2;
constexpr size_t W_VB = W_UB + al256c((size_t)DEPTH * NEXP * ROW4);
constexpr size_t W_CNAK = W_VB + al256c((size_t)DEPTH * NEXP * ROW4);
constexpr size_t W_CNAV = W_CNAK + al256c((size_t)2097152 * 2);
constexpr size_t W_CDK1 = W_CNAV + al256c((size_t)2097152 * 2);
constexpr size_t W_CDK2 = W_CDK1 + al256c((size_t)524288 * 2);
constexpr size_t W_CDV = W_CDK2 + al256c((size_t)524288 * 2);
constexpr size_t W_SGWB = W_CDV + al256c((size_t)1048576 * 2);
constexpr size_t W_MOD = W_SGWB + al256c((size_t)262144 * 2);
constexpr size_t W_ROPE = W_MOD + al256c((size_t)DEPTH * 3 * 6 * D * 4);
constexpr size_t W_LAM = W_ROPE + al256c(2048 * 4);
constexpr size_t W_VEC = W_LAM + 256;
constexpr size_t V_RPB = 0, V_SGLNG = V_RPB + 4 * 8 * 465, V_SGLNB = V_SGLNG + 4 * 512, V_SGB = V_SGLNB + 4 * 512, V_SUBG = V_SGB + 4 * 512,
                 V_LNG = V_SUBG + 4 * 128, V_LNB = V_LNG + 4 * 2 * D, V_END = V_LNB + 4 * 2 * D;
constexpr size_t W_X = W_VEC + al256c(V_END * 4);
constexpr size_t W_Y = W_X + al256c((size_t)NT * D * 4);
constexpr size_t W_H = W_Y + al256c((size_t)NT * D * 2);
constexpr size_t W_P = W_H + al256c((size_t)NT * D * 2);
constexpr size_t W_MIX = W_P + al256c((size_t)NT * INW * 2);
constexpr size_t W_QP = W_MIX + al256c((size_t)NT * D * 2);
constexpr size_t W_IDX = W_QP + al256c((size_t)NT * D * 2);
constexpr size_t W_G = W_IDX + al256c((size_t)NT * 128 * 4);
constexpr size_t W_END = W_G + al256c((size_t)NT * 128 * 4);

struct Inputs {
    const float *x_prompt, *x_sample, *c_na_k, *c_na_v, *c_df_k1, *c_df_k2, *c_df_v, *c, *c_ctx;
    const float *w_mod, *b_mod, *w_in, *na_rpb, *sg_ln_g, *sg_ln_b, *sg_w, *sg_b, *df_lambda, *df_subln_g, *w_out;
    const float *pk_wq, *pk_keys, *pk_u, *pk_v, *ln_g, *ln_b;
};
#define GAS __attribute__((address_space(1)))
struct Params {
    GAS char* ws; GAS float* out_g;
    __device__ __forceinline__ float* outp() const { return (float*)out_g; }
    __device__ __forceinline__ unsigned* bar() const { return (unsigned*)(ws + W_BAR); }
    __device__ __forceinline__ bf16_t* WinT() const { return (bf16_t*)(ws + W_WINT); }
    __device__ __forceinline__ bf16_t* WoutT() const { return (bf16_t*)(ws + W_WOUTT); }
    __device__ __forceinline__ bf16_t* WqT() const { return (bf16_t*)(ws + W_WQT); }
    __device__ __forceinline__ bf16_t* keysB() const { return (bf16_t*)(ws + W_KEYSB); }
    __device__ __forceinline__ unsigned char* Ub() const { return (unsigned char*)(ws + W_UB); }
    __device__ __forceinline__ unsigned char* Vb() const { return (unsigned char*)(ws + W_VB); }
    __device__ __forceinline__ bf16_t* cnak() const { return (bf16_t*)(ws + W_CNAK); }
    __device__ __forceinline__ bf16_t* cnav() const { return (bf16_t*)(ws + W_CNAV); }
    __device__ __forceinline__ bf16_t* cdk1() const { return (bf16_t*)(ws + W_CDK1); }
    __device__ __forceinline__ bf16_t* cdk2() const { return (bf16_t*)(ws + W_CDK2); }
    __device__ __forceinline__ bf16_t* cdv() const { return (bf16_t*)(ws + W_CDV); }
    __device__ __forceinline__ bf16_t* sgwB() const { return (bf16_t*)(ws + W_SGWB); }
    __device__ __forceinline__ float* mod() const { return (float*)(ws + W_MOD); }
    __device__ __forceinline__ float* rope() const { return (float*)(ws + W_ROPE); }
    __device__ __forceinline__ float* lam() const { return (float*)(ws + W_LAM); }
    __device__ __forceinline__ float* vec() const { return (float*)(ws + W_VEC); }
    __device__ __forceinline__ float* X() const { return (float*)(ws + W_X); }
    __device__ __forceinline__ bf16_t* Y() const { return (bf16_t*)(ws + W_Y); }
    __device__ __forceinline__ bf16_t* H() const { return (bf16_t*)(ws + W_H); }
    __device__ __forceinline__ bf16_t* P() const { return (bf16_t*)(ws + W_P); }
    __device__ __forceinline__ bf16_t* MIX() const { return (bf16_t*)(ws + W_MIX); }
    __device__ __forceinline__ bf16_t* Qp() const { return (bf16_t*)(ws + W_QP); }
    __device__ __forceinline__ int* IDX() const { return (int*)(ws + W_IDX); }
    __device__ __forceinline__ float* G() const { return (float*)(ws + W_G); }
};

__device__ __forceinline__ unsigned pack_bf2(float lo, float hi) {
    bf2_t v; v.x = (__bf16)lo; v.y = (__bf16)hi; return *(unsigned*)&v;
}
__device__ __forceinline__ float bf_lo(unsigned u) { return __uint_as_float(u << 16); }
__device__ __forceinline__ float bf_hi(unsigned u) { return __uint_as_float(u & 0xffff0000u); }
__device__ __forceinline__ float wave_sum(float v) {
#pragma unroll
    for (int s = 32; s >= 1; s >>= 1) v += __shfl_xor(v, s);
    return v;
}
__device__ __forceinline__ float lam_init_of(int l) {
    return l == 0 ? 0.2f : (l == 1 ? 0.35550907f : (l == 2 ? 0.47071302f : 0.55605820f));
}
__device__ __forceinline__ const float* xin_row(const Inputs& in, int r) {
    return r < NP ? in.x_prompt + (size_t)r * D : in.x_sample + (size_t)(r - NP) * D;
}
__device__ __forceinline__ int cond_of_row(int r) { return r < NP ? 0 : 1 + ((r - NP) >> 12); }
__device__ __forceinline__ const float* mod_ptr(const Params& p, int l, int cnd, int which) {
    return p.mod() + ((size_t)(l * 3 + cnd) * 6 + which) * D;
}

__device__ __forceinline__ int lane_id() { unsigned z = 0u; asm volatile("v_mov_b32 %0, 0" : "=v"(z)); return (int)__builtin_amdgcn_mbcnt_hi(~0u, __builtin_amdgcn_mbcnt_lo(~0u, z)); }

#define XB_TMO      128
#define XB_XCNT(j)  (256  + 64 * (j))
#define XB_XSUB(j)  (1280 + 64 * (j))
#define XB_XGEN(j)  (2304 + 64 * (j))
#define XB_TOP      3328
#define XB_TOPGEN   3392
#define XCD_BAR_WORDS 3456
#define XB_SPIN_CAP (1u << 22)

__device__ __forceinline__ unsigned xb_ld(unsigned* p)              { return __hip_atomic_load(p, __ATOMIC_RELAXED, __HIP_MEMORY_SCOPE_AGENT); }
__device__ __forceinline__ unsigned xb_add(unsigned* p, unsigned v) { return __hip_atomic_fetch_add(p, v, __ATOMIC_RELAXED, __HIP_MEMORY_SCOPE_AGENT); }
__device__ __forceinline__ unsigned xb_xcc_id() { return (unsigned)__builtin_amdgcn_s_getreg((3 << 11) | 20) & 0xFu; }
#define XB_SPIN(cond, bar) do { unsigned _sp = 0; while (cond) { __builtin_amdgcn_s_sleep(1); \
    if ((++_sp & 255u) == 0u) { if (xb_ld(&(bar)[XB_TMO])) break; if (_sp > XB_SPIN_CAP) { atomicAdd(&(bar)[XB_TMO], 1u); break; } } } } while (0)

struct XcdBarrier { unsigned* bar; unsigned x; volatile LAS unsigned* st; };

__device__ __forceinline__ XcdBarrier xcd_barrier_post(unsigned* bar, volatile LAS unsigned* st) {
    XcdBarrier b; b.bar = bar; b.x = xb_xcc_id(); b.st = st;
    if (threadIdx.x == 0) (void)xb_add(&bar[XB_XCNT(b.x)], 1u);
    return b;
}
__device__ __forceinline__ void xcd_barrier_complete(unsigned* bar, unsigned x, unsigned& nloc, unsigned& nx) {
    const unsigned G = gridDim.x * gridDim.y * gridDim.z;
    unsigned sum, cnt, mine, sp = 0u;
    for (;;) {
        sum = 0u; cnt = 0u; mine = 0u;
#pragma unroll
        for (unsigned j = 0; j < 16; ++j) { const unsigned c = xb_ld(&bar[XB_XCNT(j)]); sum += c; cnt += (c > 0u) ? 1u : 0u; mine = (j == x) ? c : mine; }
        if (sum == G) break;
        __builtin_amdgcn_s_sleep(1);
        if ((++sp & 255u) == 0u) { if (xb_ld(&bar[XB_TMO])) break; if (sp > XB_SPIN_CAP) { atomicAdd(&bar[XB_TMO], 1u); break; } }
    }
    nloc = mine > 0u ? mine : 1u; nx = cnt > 0u ? cnt : 1u;
}
__device__ __forceinline__ void xcd_barrier1(const XcdBarrier& b, int wave_s) {
    asm volatile("s_waitcnt vmcnt(0)" ::: "memory");
    __syncthreads();
    if (wave_s == 0 && lane_id() == 0) {
        unsigned* bar = b.bar; unsigned bx = b.x; asm volatile("" : "+s"(bar), "+s"(bx));
        __builtin_amdgcn_s_waitcnt(0);
        unsigned nloc = b.st[0], nx = b.st[1];
        if (nloc == 0u) { xcd_barrier_complete(bar, bx, nloc, nx); b.st[0] = nloc; b.st[1] = nx; }
        const unsigned old = xb_add(&bar[XB_XSUB(bx)], 1u);
        const unsigned gen = old / nloc;
        if (old + 1u == (gen + 1u) * nloc) {
            __builtin_amdgcn_fence(__ATOMIC_RELEASE, "agent");
            asm volatile("s_waitcnt vmcnt(0)" ::: "memory");
            const unsigned og = xb_add(&bar[XB_TOP], 1u);
            const unsigned tg = og / nx;
            if (og + 1u == (tg + 1u) * nx) xb_add(&bar[XB_TOPGEN], 1u);
            else XB_SPIN(xb_ld(&bar[XB_TOPGEN]) == tg, bar);
            __builtin_amdgcn_fence(__ATOMIC_ACQUIRE, "agent");
            xb_add(&bar[XB_XGEN(bx)], 1u);
            asm volatile("s_waitcnt vmcnt(0)" ::: "memory");
        } else {
            XB_SPIN(xb_ld(&bar[XB_XGEN(bx)]) == gen, bar);
            __builtin_amdgcn_fence(__ATOMIC_ACQUIRE, "agent");
            asm volatile("s_waitcnt vmcnt(0)" ::: "memory");
        }
    }
    __syncthreads();
}

__device__ __forceinline__ void xcd_barrier(const XcdBarrier& b, int wave_s) {
    xcd_barrier1(b, wave_s);
#if PROBE_DUP == 20
    xcd_barrier1(b, wave_s);
#endif
}

__device__ __forceinline__ void tconv_tile(const float* W, int N, bf16_t* Wt, int kt, int nt, bool permq, float* lds, int t) {
    __syncthreads();
#pragma unroll
    for (int i = 0; i < 2; ++i) {
        const int k = (t >> 4) + 32 * i, n4 = (t & 15) * 4;
        const f32x4 v = *(const f32x4*)(W + (size_t)(kt * 64 + k) * N + nt * 64 + n4);
        float* d = lds + k * 65 + n4;
        d[0] = v[0]; d[1] = v[1]; d[2] = v[2]; d[3] = v[3];
    }
    __syncthreads();
    const int q = t >> 3, k8 = (t & 7) * 8;
    const int dl = permq ? ((((q >> 4) & 1) << 5) | ((q >> 5) << 4) | (q & 15)) : q;
    u32x4 o;
    o[0] = pack_bf2(lds[(k8 + 0) * 65 + dl], lds[(k8 + 1) * 65 + dl]);
    o[1] = pack_bf2(lds[(k8 + 2) * 65 + dl], lds[(k8 + 3) * 65 + dl]);
    o[2] = pack_bf2(lds[(k8 + 4) * 65 + dl], lds[(k8 + 5) * 65 + dl]);
    o[3] = pack_bf2(lds[(k8 + 6) * 65 + dl], lds[(k8 + 7) * 65 + dl]);
    *(u32x4*)(Wt + (size_t)(nt * 64 + q) * D + kt * 64 + k8) = o;
}

__device__ __forceinline__ void conv_chunk(const float* src, bf16_t* dst, size_t chunk, int t) {
    const size_t e = chunk * 4096 + (size_t)t * 8;
    const f32x4 a = *(const f32x4*)(src + e), b = *(const f32x4*)(src + e + 4);
    u32x4 o; o[0] = pack_bf2(a[0], a[1]); o[1] = pack_bf2(a[2], a[3]); o[2] = pack_bf2(b[0], b[1]); o[3] = pack_bf2(b[2], b[3]);
    *(u32x4*)(dst + e) = o;
}

constexpr float U_SCALE = 92.0f, V_SCALE = 13.75f;
__device__ __forceinline__ void conv_chunk_fp4(const float* src, unsigned char* dst, size_t chunk, int t, float scale) {
    const size_t e = chunk * 16384 + (size_t)t * 32;
    u32x4 o;
#pragma unroll
    for (int w = 0; w < 4; ++w) {
        const f32x4 x0 = *(const f32x4*)(src + e + 8 * w), x1 = *(const f32x4*)(src + e + 8 * w + 4);
        unsigned r = 0;
        r = __builtin_amdgcn_cvt_scalef32_pk_fp4_f32(r, x0[0] * scale, x0[1] * scale, 1.0f, 0);
        r = __builtin_amdgcn_cvt_scalef32_pk_fp4_f32(r, x0[2] * scale, x0[3] * scale, 1.0f, 1);
        r = __builtin_amdgcn_cvt_scalef32_pk_fp4_f32(r, x1[0] * scale, x1[1] * scale, 1.0f, 2);
        r = __builtin_amdgcn_cvt_scalef32_pk_fp4_f32(r, x1[2] * scale, x1[3] * scale, 1.0f, 3);
        o[w] = r;
    }
    *(u32x4*)(dst + (e / 32) * 16) = o;
}

__device__ __forceinline__ void conv_chunk_fp4v(const float* src, unsigned char* dst, size_t chunk, int t, float scale) {
    const size_t e = chunk * 16384 + (size_t)t * 32;
    const int tq = t & 63, q = tq >> 4, fq = (tq >> 2) & 3, jh = (tq >> 1) & 1, nh = tq & 1;
    float x[32];
#pragma unroll
    for (int i = 0; i < 8; ++i) {
        const f32x4 v = *(const f32x4*)(src + e + 4 * i);
        x[4 * i] = v[0] * scale; x[4 * i + 1] = v[1] * scale; x[4 * i + 2] = v[2] * scale; x[4 * i + 3] = v[3] * scale;
    }
    unsigned char* o = dst + (e / D) * ROW4 + q * 256 + fq * 64 + jh * 8 + nh * 4;
#pragma unroll
    for (int reg = 0; reg < 4; ++reg) {
        unsigned r = 0;
        r = __builtin_amdgcn_cvt_scalef32_pk_fp4_f32(r, x[reg], x[4 + reg], 1.0f, 0);
        r = __builtin_amdgcn_cvt_scalef32_pk_fp4_f32(r, x[8 + reg], x[12 + reg], 1.0f, 1);
        r = __builtin_amdgcn_cvt_scalef32_pk_fp4_f32(r, x[16 + reg], x[20 + reg], 1.0f, 2);
        r = __builtin_amdgcn_cvt_scalef32_pk_fp4_f32(r, x[24 + reg], x[28 + reg], 1.0f, 3);
        *(unsigned*)(o + reg * 16) = r;
    }
}

__device__ __forceinline__ void phase_prologue0(const Params& p, const Inputs& in, char* smem, int tid) {
    float* lds = (float*)smem;
    const int t = tid, nb = gridDim.x, bid = blockIdx.x;
    {
        float* sc = lds;
        float* red = lds + 3 * D;
        for (int i = t; i < 3 * D; i += 512) {
            const int cnd = i / D, k = i % D;
            const float v = cnd == 0 ? in.c_ctx[k] : in.c[(cnd - 1) * D + k];
            sc[i] = v / (1.0f + __expf(-v));
        }
        __syncthreads();
        for (int u = bid; u < DEPTH * 192; u += nb) {
            const int l = u / 192, c0 = (u % 192) * 64;
            const int cg = t & 15, ks = t >> 4;
            float acc[3][4];
#pragma unroll
            for (int a = 0; a < 3; ++a)
#pragma unroll
                for (int j = 0; j < 4; ++j) acc[a][j] = 0.f;
            const float* wp = in.w_mod + ((size_t)l * D + ks * 64) * (6 * D) + c0 + cg * 4;
#pragma unroll 4
            for (int k = 0; k < 64; ++k) {
                const f32x4 w = *(const f32x4*)(wp + (size_t)k * (6 * D));
#pragma unroll
                for (int a = 0; a < 3; ++a) {
                    const float s = sc[a * D + ks * 64 + k];
#pragma unroll
                    for (int j = 0; j < 4; ++j) acc[a][j] += s * w[j];
                }
            }
#pragma unroll
            for (int a = 0; a < 3; ++a)
#pragma unroll
                for (int j = 0; j < 4; ++j) red[(ks * 16 + cg) * 12 + a * 4 + j] = acc[a][j];
            __syncthreads();
            if (t < 192) {
                const int cg2 = t / 12, aj = t % 12, a = aj >> 2, j = aj & 3;
                float s = 0.f;
                for (int k2 = 0; k2 < 32; ++k2) s += red[(k2 * 16 + cg2) * 12 + aj];
                const int col = c0 + cg2 * 4 + j;
                p.mod()[(size_t)(l * 3 + a) * (6 * D) + col] = s + in.b_mod[(size_t)l * 6 * D + col];
            }
            __syncthreads();
        }
    }
    if (bid == 0) {
        for (int i = t; i < 1024; i += 512) {
            const int pos = i >> 4, f = i & 15;
            const float inv = 1.0f / powf(10000.0f, (float)f / 16.0f);
            const float ang = (float)pos * inv;
            p.rope()[2 * i] = cosf(ang); p.rope()[2 * i + 1] = sinf(ang);
        }
        if (t < DEPTH) {
            const float* lp = in.df_lambda + t * 256;
            float a = 0.f, b = 0.f;
            for (int i = 0; i < 64; ++i) { a += lp[i] * lp[64 + i]; b += lp[128 + i] * lp[192 + i]; }
            p.lam()[t] = expf(a) - expf(b) + lam_init_of(t);
        }
    }
    {
        float* vv = p.vec();
        for (int i = bid * 512 + t; i < (int)V_END; i += nb * 512) {
            float v;
            if (i < (int)V_SGLNG) v = in.na_rpb[i - V_RPB];
            else if (i < (int)V_SGLNB) v = in.sg_ln_g[i - V_SGLNG];
            else if (i < (int)V_SGB) v = in.sg_ln_b[i - V_SGLNB];
            else if (i < (int)V_SUBG) v = in.sg_b[i - V_SGB];
            else if (i < (int)V_LNG) v = in.df_subln_g[i - V_SUBG];
            else if (i < (int)V_LNB) v = in.ln_g[i - V_LNG];
            else v = in.ln_b[i - V_LNB];
            vv[i] = v;
        }
    }
    {
        const int n_in = DEPTH * 32 * 88, n_sq = DEPTH * 32 * 32;
        for (int u = bid; u < n_in + 2 * n_sq; u += nb) {
            if (u < n_in) {
                const int l = u / (32 * 88), r = u % (32 * 88), nt = r / 32, kt = r % 32;
                const bool pq = (nt >= 64 && nt < 80);
                tconv_tile(in.w_in + (size_t)l * D * INW, INW, p.WinT() + (size_t)l * INW * D, kt, nt, pq, lds, t);
            } else if (u < n_in + n_sq) {
                const int v = u - n_in, l = v / 1024, r = v % 1024, nt = r / 32, kt = r % 32;
                tconv_tile(in.w_out + (size_t)l * D * D, D, p.WoutT() + (size_t)l * D * D, kt, nt, false, lds, t);
            } else {
                const int v = u - n_in - n_sq, l = v / 1024, r = v % 1024, nt = r / 32, kt = r % 32;
                tconv_tile(in.pk_wq + (size_t)l * D * D, D, p.WqT() + (size_t)l * D * D, kt, nt, false, lds, t);
            }
        }
    }
    {
        const size_t nU = (size_t)NEXP * D / 16384;
        const size_t n0 = 2 * nU, n1 = n0 + 512, n2 = n1 + 512, n3 = n2 + 128, n4 = n3 + 128, n5 = n4 + 256, n6 = n5 + 64, n7 = n6 + 256;
        for (size_t u = bid; u < n7; u += nb) {
            if (u < nU) conv_chunk_fp4(in.pk_u, p.Ub(), u, t, U_SCALE);
            else if (u < n0) conv_chunk_fp4v(in.pk_v, p.Vb(), u - nU, t, V_SCALE);
            else if (u < n1) conv_chunk(in.c_na_k, p.cnak(), u - n0, t);
            else if (u < n2) conv_chunk(in.c_na_v, p.cnav(), u - n1, t);
            else if (u < n3) conv_chunk(in.c_df_k1, p.cdk1(), u - n2, t);
            else if (u < n4) conv_chunk(in.c_df_k2, p.cdk2(), u - n3, t);
            else if (u < n5) conv_chunk(in.c_df_v, p.cdv(), u - n4, t);
            else if (u < n6) conv_chunk(in.sg_w, p.sgwB(), u - n5, t);
            else conv_chunk(in.pk_keys, p.keysB(), u - n6, t);
        }
    }
}

__device__ __forceinline__ void phase_prologue1(const Params& p, const Inputs& in, int tid) {
    const int lane = tid & 63, wv = blockIdx.x * 8 + (tid >> 6), nw = gridDim.x * 8;
    for (int r = wv; r < NT; r += nw) {
        const float* x = xin_row(in, r);
        const int cnd = cond_of_row(r);
        const float* sh = mod_ptr(p, 0, cnd, 0); const float* sc = mod_ptr(p, 0, cnd, 1);
#pragma unroll
        for (int i = 0; i < 4; ++i) {
            const int e = i * 512 + lane * 8;
            const f32x4 a = *(const f32x4*)(x + e), b = *(const f32x4*)(x + e + 4);
            *(f32x4*)(p.X() + (size_t)r * D + e) = a; *(f32x4*)(p.X() + (size_t)r * D + e + 4) = b;
            const f32x4 s0 = *(const f32x4*)(sc + e), s1 = *(const f32x4*)(sc + e + 4);
            const f32x4 h0 = *(const f32x4*)(sh + e), h1 = *(const f32x4*)(sh + e + 4);
            u32x4 o;
            o[0] = pack_bf2(a[0] * (1.f + s0[0]) + h0[0], a[1] * (1.f + s0[1]) + h0[1]);
            o[1] = pack_bf2(a[2] * (1.f + s0[2]) + h0[2], a[3] * (1.f + s0[3]) + h0[3]);
            o[2] = pack_bf2(b[0] * (1.f + s1[0]) + h1[0], b[1] * (1.f + s1[1]) + h1[1]);
            o[3] = pack_bf2(b[2] * (1.f + s1[2]) + h1[2], b[3] * (1.f + s1[3]) + h1[3]);
            *(u32x4*)(p.H() + (size_t)r * D + e) = o;
        }
    }
}

template <int CW>
__device__ __forceinline__ void ln_row_finish(const Params& p, int r, int lane, const float* xrow, const float (&y)[32], const float* gate,
                                              const float* lng, const float* lnb, float* xout, bool nxt, const float* scn, const float* shn) {
    constexpr int NCH = 32 / CW, NV = CW / 4;
    float t[32];
    float s = 0.f;
#pragma unroll
    for (int i = 0; i < NCH; ++i)
#pragma unroll
        for (int v = 0; v < NV; ++v) {
            const int e = i * 64 * CW + lane * CW + 4 * v;
            const f32x4 a = *(const f32x4*)(xrow + e), g0 = *(const f32x4*)(gate + e);
#pragma unroll
            for (int j = 0; j < 4; ++j) t[i * CW + 4 * v + j] = DN_ALPHA * a[j] + g0[j] * y[i * CW + 4 * v + j];
        }
#pragma unroll
    for (int i = 0; i < 32; ++i) s += t[i];
    const float mean = wave_sum(s) * (1.0f / D);
    float q = 0.f;
#pragma unroll
    for (int i = 0; i < 32; ++i) { const float d = t[i] - mean; q += d * d; }
    const float rstd = rsqrtf(wave_sum(q) * (1.0f / D) + 1e-5f);
#pragma unroll
    for (int i = 0; i < NCH; ++i)
#pragma unroll
        for (int v = 0; v < NV; v += 2) {
            const int e = i * 64 * CW + lane * CW + 4 * v;
            const f32x4 g0 = *(const f32x4*)(lng + e), g1 = *(const f32x4*)(lng + e + 4);
            const f32x4 b0 = *(const f32x4*)(lnb + e), b1 = *(const f32x4*)(lnb + e + 4);
            f32x4 o0, o1;
#pragma unroll
            for (int j = 0; j < 4; ++j) {
                o0[j] = (t[i * CW + 4 * v + j] - mean) * rstd * g0[j] + b0[j];
                o1[j] = (t[i * CW + 4 * v + 4 + j] - mean) * rstd * g1[j] + b1[j];
            }
            *(f32x4*)(xout + e) = o0; *(f32x4*)(xout + e + 4) = o1;
            if (nxt) {
                const f32x4 s0 = *(const f32x4*)(scn + e), s1 = *(const f32x4*)(scn + e + 4);
                const f32x4 h0 = *(const f32x4*)(shn + e), h1 = *(const f32x4*)(shn + e + 4);
                u32x4 o;
                o[0] = pack_bf2(o0[0] * (1.f + s0[0]) + h0[0], o0[1] * (1.f + s0[1]) + h0[1]);
                o[1] = pack_bf2(o0[2] * (1.f + s0[2]) + h0[2], o0[3] * (1.f + s0[3]) + h0[3]);
                o[2] = pack_bf2(o1[0] * (1.f + s1[0]) + h1[0], o1[1] * (1.f + s1[1]) + h1[1]);
                o[3] = pack_bf2(o1[2] * (1.f + s1[2]) + h1[2], o1[3] * (1.f + s1[3]) + h1[3]);
                *(u32x4*)(p.H() + (size_t)r * D + e) = o;
            }
        }
}

__device__ __forceinline__ void ln_row_finish_q(const Params& p, int r, int lane, const float* xrow, const f32x4 (&y)[8], const float* gate,
                                                const float* lng, const float* lnb, float* xout, bool nxt, const float* scn, const float* shn) {
    const int lo = (lane >> 4) * 128 + (lane & 15) * 4;
    f32x4 t[8];
    float s = 0.f;
#pragma unroll
    for (int c = 0; c < 8; ++c) {
        const int e = (c >> 1) * 512 + (c & 1) * 64 + lo;
        const f32x4 a = *(const f32x4*)(xrow + e), g0 = *(const f32x4*)(gate + e);
#pragma unroll
        for (int j = 0; j < 4; ++j) { t[c][j] = DN_ALPHA * a[j] + g0[j] * y[c][j]; s += t[c][j]; }
    }
    const float mean = wave_sum(s) * (1.0f / D);
    float q = 0.f;
#pragma unroll
    for (int c = 0; c < 8; ++c)
#pragma unroll
        for (int j = 0; j < 4; ++j) { const float d = t[c][j] - mean; q += d * d; }
    const float rstd = rsqrtf(wave_sum(q) * (1.0f / D) + 1e-5f);
#pragma unroll
    for (int c = 0; c < 8; ++c) {
        const int e = (c >> 1) * 512 + (c & 1) * 64 + lo;
        const f32x4 g0 = *(const f32x4*)(lng + e), b0 = *(const f32x4*)(lnb + e);
        f32x4 o0;
#pragma unroll
        for (int j = 0; j < 4; ++j) o0[j] = (t[c][j] - mean) * rstd * g0[j] + b0[j];
        *(f32x4*)(xout + e) = o0;
        if (nxt) {
            const f32x4 s0 = *(const f32x4*)(scn + e), h0 = *(const f32x4*)(shn + e);
            u32x2 o;
            o[0] = pack_bf2(o0[0] * (1.f + s0[0]) + h0[0], o0[1] * (1.f + s0[1]) + h0[1]);
            o[1] = pack_bf2(o0[2] * (1.f + s0[2]) + h0[2], o0[3] * (1.f + s0[3]) + h0[3]);
            *(u32x2*)(p.H() + (size_t)r * D + e) = o;
        }
    }
}

__device__ __forceinline__ void phase_ln1(const Params& p, int l, int tid) {
    const int lane = tid & 63, wv = blockIdx.x * 8 + (tid >> 6), nw = gridDim.x * 8;
    for (int r = wv; r < NT; r += nw) {
        const int cnd = cond_of_row(r);
        const float* xrow = p.X() + (size_t)r * D;
        float y[32];
#pragma unroll
        for (int i = 0; i < 4; ++i) {
            const int e = i * 512 + lane * 8;
            const u32x4 a = *(const u32x4*)(p.Y() + (size_t)r * D + e);
#pragma unroll
            for (int j = 0; j < 4; ++j) { y[i * 8 + 2 * j] = bf_lo(a[j]); y[i * 8 + 2 * j + 1] = bf_hi(a[j]); }
        }
        ln_row_finish<8>(p, r, lane, xrow, y, mod_ptr(p, l, cnd, 2), p.vec() + V_LNG + (size_t)(l * 2) * D, p.vec() + V_LNB + (size_t)(l * 2) * D,
                      p.X() + (size_t)r * D, true, mod_ptr(p, l, cnd, 4), mod_ptr(p, l, cnd, 3));
    }
}

constexpr int BM = 256, BK = 64, HALF = 128, HT = HALF * BK;
__device__ __forceinline__ int lds_byte(int r, int c) {
    int st = (r >> 4) * 2 + (c >> 5), rr = r & 15, cc = c & 31, ob = rr * 64 + cc * 2;
    return st * 1024 + (ob ^ (((ob >> 9) & 1) << 5));
}
__device__ __forceinline__ void stage_rc(int b, int& R, int& C) {
    int st = b / 1024, sb = b % 1024, swz = sb ^ (((sb >> 9) & 1) << 5);
    R = (st >> 1) * 16 + swz / 64; C = (st & 1) * 32 + (swz % 64) / 2;
}

template <class Epi>
__device__ __forceinline__ void gemm_tile(__amdgpu_buffer_rsrc_t A, __amdgpu_buffer_rsrc_t Bt, int brow, int bcol, bf16_t* shm, const Epi& epi, int tid) {
    constexpr int K = D;
#define SA(b, h) (shm + ((b) * 2 + (h)) * HT)
#define SB(b, h) (shm + (4 + (b) * 2 + (h)) * HT)
#define STAGE_X(T, P, RS, br, kt) do { const unsigned _so = (unsigned)(((br) * K + (kt) * BK) * 2); \
    __builtin_amdgcn_raw_ptr_buffer_load_lds(RS, (LAS void*)((char*)(P) + wbase), 16, so0, _so, 0, 0); \
    __builtin_amdgcn_raw_ptr_buffer_load_lds(RS, (LAS void*)((char*)(P) + wbase + 8192), 16, so1, _so, 0, 0); } while (0)
#define STAGE(P, RS, br, kt) STAGE_X(tid, P, RS, br, kt)
#define LDA(dst, b, h) for (int m = 0; m < 4; ++m) for (int k = 0; k < 2; ++k) \
    dst[m][k] = *reinterpret_cast<const bf16x8*>((char*)SA(b, h) + lds_byte(wr * 64 + m * 16 + fr, k * 32 + fq * 8))
#define LDB(dst, b, h) for (int n = 0; n < 2; ++n) for (int k = 0; k < 2; ++k) \
    dst[n][k] = *reinterpret_cast<const bf16x8*>((char*)SB(b, h) + lds_byte(wc * 32 + n * 16 + fr, k * 32 + fq * 8))
#define MMA(ai, bj, At, Bf) do { __builtin_amdgcn_s_setprio(1); \
    for (int m = 0; m < 4; ++m) for (int n = 0; n < 2; ++n) for (int k = 0; k < 2; ++k) \
      acc[ai][bj][m][n] = __builtin_amdgcn_mfma_f32_16x16x32_bf16(Bf[n][k], At[m][k], acc[ai][bj][m][n], 0, 0, 0); \
    __builtin_amdgcn_s_setprio(0); } while (0)
#define WAIT_V(n) asm volatile("s_waitcnt vmcnt(" #n ")" ::: "memory")
#define WAIT_L(n) asm volatile("s_waitcnt lgkmcnt(" #n ")" ::: "memory")
#define BAR __builtin_amdgcn_s_barrier()
#define SCHED __builtin_amdgcn_sched_barrier(0)
    int wid = tid >> 6, lane = tid & 63, wr = wid >> 2, wc = wid & 3, fr = lane & 15, fq = lane >> 4;
    f32x4 acc[2][2][4][2] = {};
    bf16x8 At[4][2], B0[2][2], B1[2][2];
    constexpr int nt = K / BK;
    const unsigned wbase = (unsigned)__builtin_amdgcn_readfirstlane(tid >> 6) * 1024u;
    unsigned so0, so1;
    { int r_, c_; stage_rc(tid * 16, r_, c_); so0 = (unsigned)(r_ * K + c_) * 2u; stage_rc(tid * 16 + 8192, r_, c_); so1 = (unsigned)(r_ * K + c_) * 2u; }
    STAGE(SB(0, 0), Bt, bcol, 0); STAGE(SA(0, 0), A, brow, 0);
    STAGE(SB(0, 1), Bt, bcol + HALF, 0); STAGE(SA(0, 1), A, brow + HALF, 0);
    if (wr == 1) BAR;
    WAIT_V(4); BAR;
    STAGE(SB(1, 0), Bt, bcol, 1); STAGE(SA(1, 0), A, brow, 1); STAGE(SB(1, 1), Bt, bcol + HALF, 1);
    WAIT_V(6); BAR;
    for (int t = 0; t < nt - 2; t += 2) {
        LDB(B0, 0, 0); SCHED; LDA(At, 0, 0); STAGE(SA(1, 1), A, brow + HALF, t + 1);
        WAIT_L(8); BAR; WAIT_L(0); MMA(0, 0, At, B0); BAR; SCHED;
        LDB(B1, 0, 1); STAGE(SB(0, 0), Bt, bcol, t + 2);
        BAR; WAIT_L(0); MMA(0, 1, At, B1); BAR;
        LDA(At, 0, 1); STAGE(SA(0, 0), A, brow, t + 2);
        BAR; WAIT_L(0); MMA(1, 0, At, B0); BAR; SCHED;
        STAGE(SB(0, 1), Bt, bcol + HALF, t + 2);
        WAIT_V(6); BAR; MMA(1, 1, At, B1); BAR;
        LDB(B0, 1, 0); SCHED; LDA(At, 1, 0); STAGE(SA(0, 1), A, brow + HALF, t + 2);
        WAIT_L(8); BAR; WAIT_L(0); MMA(0, 0, At, B0); BAR; SCHED;
        LDB(B1, 1, 1); STAGE(SB(1, 0), Bt, bcol, t + 3);
        BAR; WAIT_L(0); MMA(0, 1, At, B1); BAR;
        LDA(At, 1, 1); STAGE(SA(1, 0), A, brow, t + 3);
        BAR; WAIT_L(0); MMA(1, 0, At, B0); BAR; SCHED;
        STAGE(SB(1, 1), Bt, bcol + HALF, t + 3);
        WAIT_V(6); BAR; MMA(1, 1, At, B1); BAR;
    }
    int tz = tid; asm volatile("" : "+v"(tz)); wid = tz >> 6; lane = tz & 63; wr = wid >> 2; wc = wid & 3; fr = lane & 15; fq = lane >> 4;
    { LDB(B0, 0, 0); WAIT_V(0); LDA(At, 0, 0); STAGE_X(tz, SA(1, 1), A, brow + HALF, nt - 1);
      BAR; WAIT_L(0); MMA(0, 0, At, B0); BAR;
      LDB(B1, 0, 1); BAR; WAIT_L(0); MMA(0, 1, At, B1); BAR;
      LDA(At, 0, 1); WAIT_V(4); BAR; WAIT_L(0); MMA(1, 0, At, B0); MMA(1, 1, At, B1); BAR; }
    { LDB(B0, 1, 0); LDA(At, 1, 0); WAIT_V(2); BAR; WAIT_L(0); MMA(0, 0, At, B0); BAR;
      LDB(B1, 1, 1); WAIT_V(0); BAR; WAIT_L(0); MMA(0, 1, At, B1); BAR;
      LDA(At, 1, 1); BAR; WAIT_L(0); MMA(1, 0, At, B0); MMA(1, 1, At, B1); BAR; }
    if (wr == 0) BAR;
    epi(acc, brow, bcol, wr, wc, fr, fq, (char*)shm, tz);
#undef SA
#undef SB
#undef STAGE_X
#undef STAGE
#undef LDA
#undef LDB
#undef MMA
}

__device__ __forceinline__ bool tile_of(int i, int nM, int nN, int& pm, int& pn) {
    const int nwg = nM * nN;
    const long L = (long)i * gridDim.x + blockIdx.x;
    if (L >= nwg) return false;
    int wgid = (int)L;
    { const int q = nwg / 8, r = nwg % 8, xcd = wgid % 8, off = wgid / 8; wgid = (xcd < r ? xcd * (q + 1) : r * (q + 1) + (xcd - r) * q) + off; }
    constexpr int WGM = 4;
    const int nig = WGM * nN, gid = wgid / nig, fm = gid * WGM, gsz = (nM - fm) < WGM ? (nM - fm) : WGM;
    pm = fm + ((wgid % nig) % gsz); pn = (wgid % nig) / gsz;
    return true;
}

constexpr int EPI_RS = 528;
__device__ __forceinline__ void epi_flush_bf16(const char* img, bf16_t* C, int ldc, int tid) {
    __syncthreads();
    const int r0 = (tid >> 6) * 32 + ((tid & 63) >> 5), cb = (tid & 31) * 16;
#pragma unroll 1
    for (int h = 0; h < 2; ++h) {
        u32x4 v[8];
#pragma unroll
        for (int i = 0; i < 8; ++i) v[i] = *(const u32x4*)(img + (r0 + 16 * h + 2 * i) * EPI_RS + cb);
#pragma unroll
        for (int i = 0; i < 8; ++i) __builtin_nontemporal_store(v[i], (u32x4*)((char*)(C + (size_t)(r0 + 16 * h + 2 * i) * ldc) + cb));
    }
    __syncthreads();
}

struct EpiProj {
    const Params* pp; int l;
    __device__ __forceinline__ void operator()(const f32x4 (&acc)[2][2][4][2], int brow, int bcol, int wr, int wc, int fr, int fq, char* img, int tid) const {
        const Params& p = *pp;
        const int pn = bcol >> 8;
        const bool prompt = brow < NP;
        if (pn >= 16 && pn < 20) {
#pragma unroll
            for (int ai = 0; ai < 2; ++ai)
#pragma unroll
                for (int m = 0; m < 4; ++m) {
                    const int row = brow + ai * HALF + wr * 64 + m * 16 + fr;
#pragma unroll
                    for (int bj = 0; bj < 2; ++bj) {
                        const int hh = bj * 2 + (wc >> 1);
                        const int i0 = (wc & 1) * 16 + 4 * fq;
                        f32x4 x1 = acc[ai][bj][m][0], x2 = acc[ai][bj][m][1];
                        if (!prompt) {
                            const int tk = (row - NP) & 4095;
                            const int pos = (wc & 1) ? (tk & 63) : (tk >> 6);
                            const float* cs = p.rope() + (size_t)(pos * 16 + 4 * fq) * 2;
                            const f32x4 c01 = *(const f32x4*)cs, c23 = *(const f32x4*)(cs + 4);
                            const float cc[4] = {c01[0], c01[2], c23[0], c23[2]}, ss[4] = {c01[1], c01[3], c23[1], c23[3]};
                            f32x4 y1, y2;
#pragma unroll
                            for (int j = 0; j < 4; ++j) { y1[j] = x1[j] * cc[j] - x2[j] * ss[j]; y2[j] = x1[j] * ss[j] + x2[j] * cc[j]; }
                            x1 = y1; x2 = y2;
                        }
                        char* pr = img + (row - brow) * EPI_RS + (hh * 64 + i0) * 2;
                        u32x2 o1, o2;
                        o1[0] = pack_bf2(x1[0], x1[1]); o1[1] = pack_bf2(x1[2], x1[3]);
                        o2[0] = pack_bf2(x2[0], x2[1]); o2[1] = pack_bf2(x2[2], x2[3]);
                        *(u32x2*)pr = o1; *(u32x2*)(pr + 64) = o2;
                    }
                }
        } else {
#pragma unroll
            for (int ai = 0; ai < 2; ++ai)
#pragma unroll
                for (int m = 0; m < 4; ++m) {
                    const int row = brow + ai * HALF + wr * 64 + m * 16 + fr;
#pragma unroll
                    for (int bj = 0; bj < 2; ++bj)
#pragma unroll
                        for (int n = 0; n < 2; ++n) {
                            const int col = bcol + bj * HALF + wc * 32 + n * 16 + 4 * fq;
                            const f32x4 v = acc[ai][bj][m][n];
                            u32x2 o; o[0] = pack_bf2(v[0], v[1]); o[1] = pack_bf2(v[2], v[3]);
                            *(u32x2*)(img + (row - brow) * EPI_RS + (col - bcol) * 2) = o;
                        }
                }
        }
        epi_flush_bf16(img, p.P() + (size_t)brow * INW + bcol, INW, tid);
        float* ob = nullptr; int hd = 128, nh = 8, hbase = 0;
        if (prompt) {
            if (pn >= 4 && pn < 8) { ob = p.outp() + O_NAK; hbase = (bcol - C_KA) >> 7; }
            else if (pn >= 8 && pn < 12) { ob = p.outp() + O_NAV; hbase = (bcol - C_VA) >> 7; }
            else if (pn >= 20) { ob = p.outp() + O_DFV; hbase = (bcol - C_VC) >> 7; nh = 4; }
            else if (pn == 18) { ob = p.outp() + O_K1; hd = 64; nh = 4; }
            else if (pn == 19) { ob = p.outp() + O_K2; hd = 64; nh = 4; }
        }
        if (ob) {
            const int b = brow >> 8;
#pragma unroll
            for (int hb = 0; hb < 2; ++hb) {
#pragma unroll
                for (int ai = 0; ai < 2; ++ai)
#pragma unroll
                    for (int m = 0; m < 4; ++m) {
                        char* rp = img + (ai * HALF + wr * 64 + m * 16 + fr) * EPI_RS;
                        if (hd == 64) {
                            const int cf = (wc >> 1) * 64 + (wc & 1) * 16 + 4 * fq;
                            *(f32x4*)(rp + cf * 4) = acc[ai][hb][m][0]; *(f32x4*)(rp + (cf + 32) * 4) = acc[ai][hb][m][1];
                        } else {
#pragma unroll
                            for (int n = 0; n < 2; ++n) *(f32x4*)(rp + (wc * 32 + n * 16 + 4 * fq) * 4) = acc[ai][hb][m][n];
                        }
                    }
                __syncthreads();
                const int r0 = (tid >> 6) * 32 + ((tid & 63) >> 5), c4 = tid & 31;
                float* dst = hd == 64 ? ob + (((size_t)b * DEPTH + l) * 4 + 2 * hb + (c4 >> 4)) * 256 * 64 + (c4 & 15) * 4
                                      : ob + (((size_t)b * DEPTH + l) * nh + hbase + hb) * 256 * 128 + c4 * 4;
#pragma unroll 1
                for (int h2 = 0; h2 < 2; ++h2) {
                    f32x4 v[8];
#pragma unroll
                    for (int i = 0; i < 8; ++i) v[i] = *(const f32x4*)(img + (r0 + 16 * h2 + 2 * i) * EPI_RS + c4 * 16);
#pragma unroll
                    for (int i = 0; i < 8; ++i) __builtin_nontemporal_store(v[i], (f32x4*)(dst + (size_t)(r0 + 16 * h2 + 2 * i) * hd));
                }
                __syncthreads();
            }
        }
    }
};
struct EpiF32 {
    float* C; int ldc;
    __device__ __forceinline__ void operator()(const f32x4 (&acc)[2][2][4][2], int brow, int bcol, int wr, int wc, int fr, int fq, char*, int) const {
#pragma unroll
        for (int ai = 0; ai < 2; ++ai)
#pragma unroll
            for (int m = 0; m < 4; ++m) {
                float* rp = C + (size_t)(brow + ai * HALF + wr * 64 + m * 16 + fr) * ldc + bcol + wc * 32 + 4 * fq;
#pragma unroll
                for (int bj = 0; bj < 2; ++bj)
#pragma unroll
                    for (int n = 0; n < 2; ++n) *(f32x4*)(rp + bj * HALF + n * 16) = acc[ai][bj][m][n];
            }
    }
};
struct EpiBf16 {
    bf16_t* C; int ldc;
    __device__ __forceinline__ void operator()(const f32x4 (&acc)[2][2][4][2], int brow, int bcol, int wr, int wc, int fr, int fq, char* img, int tid) const {
#pragma unroll
        for (int ai = 0; ai < 2; ++ai)
#pragma unroll
            for (int m = 0; m < 4; ++m) {
                char* rp = img + (ai * HALF + wr * 64 + m * 16 + fr) * EPI_RS + (wc * 32 + 4 * fq) * 2;
#pragma unroll
                for (int bj = 0; bj < 2; ++bj)
#pragma unroll
                    for (int n = 0; n < 2; ++n) {
                        const f32x4 v = acc[ai][bj][m][n];
                        u32x2 o; o[0] = pack_bf2(v[0], v[1]); o[1] = pack_bf2(v[2], v[3]);
                        *(u32x2*)(rp + (bj * HALF + n * 16) * 2) = o;
                    }
            }
        epi_flush_bf16(img, C + (size_t)brow * ldc + bcol, ldc, tid);
    }
};

template <class Epi>
__device__ __forceinline__ void gemm_phase(const bf16_t* A, const bf16_t* Bt, int M, int N, char* smem, const Epi& epi, int tid) {
    const int nM = M / BM, nN = N / BM;
    const __amdgpu_buffer_rsrc_t rA = __builtin_amdgcn_make_buffer_rsrc((void*)A, 0, M * D * 2, 0x00020000);
    const __amdgpu_buffer_rsrc_t rB = __builtin_amdgcn_make_buffer_rsrc((void*)Bt, 0, N * D * 2, 0x00020000);
    for (int i = 0;; ++i) {
        int pm, pn;
        if (!tile_of(i, nM, nN, pm, pn)) break;
        gemm_tile(rA, rB, pm * BM, pn * BM, (bf16_t*)smem, epi, tid);
        __syncthreads();
    }
}

struct AttnArgs {
    const bf16_t* q[2]; int ldq;
    const bf16_t* k[2][2]; const bf16_t* v[2];
    int ldk[2], ldv[2], nt[2];
    bf16_t* o;
    float scale_l2;
    const float* rpb; int r, r0;
    float lam, oml; const float* subg;
};
constexpr int VSTR = 288;
constexpr int ATT_GROUP_LDS = 40960;

template <int NMAP, int DQK, bool NA, bool SHARE>
__device__ __forceinline__ void attn_group(const AttnArgs& a, char* lds, int gtid, int ltid) {
    constexpr int NTH = SHARE ? 512 : 256;
    constexpr int TK = 64;
    constexpr int NSUB = TK / 64;
    constexpr int KSTR = DQK * 2;
    constexpr int KCH = DQK / 8;
    constexpr int KPT = NMAP * TK * KCH / NTH;
    constexpr int VPT = TK * 16 / NTH;
    constexpr int NS_ = DQK / 32;
    constexpr bool DB = SHARE;
    constexpr int BUFSZ = NMAP * TK * KSTR + TK * VSTR;
    char* Kt = lds;
    char* Vt = lds + NMAP * TK * KSTR;
    float* rpbl = (float*)(lds + BUFSZ);
    const int lane = gtid & 63, wg = gtid >> 6, fr = lane & 15, fq = lane >> 4;

    if (NA) { for (int i = gtid; i < 465; i += 256) rpbl[i] = a.rpb[i] * LOG2E; }

    bf16x8 Qf[NMAP][NS_];
#pragma unroll
    for (int mp = 0; mp < NMAP; ++mp)
#pragma unroll
        for (int s = 0; s < NS_; ++s)
            Qf[mp][s] = *(const bf16x8*)(a.q[mp] + (size_t)(wg * 16 + fr) * a.ldq + 32 * s + 8 * fq);

    f32x4 O[NMAP][8];
    float mrun[NMAP], lrun[NMAP];
#pragma unroll
    for (int mp = 0; mp < NMAP; ++mp) {
        mrun[mp] = -1e30f; lrun[mp] = 0.f;
#pragma unroll
        for (int c = 0; c < 8; ++c) O[mp][c] = (f32x4){0.f, 0.f, 0.f, 0.f};
    }

    const int T = (a.nt[0] + a.nt[1]) / NSUB;
    const int T0 = a.nt[0] / NSUB;
    int na_lo = 0, na_hi = 63;
    if (NA) { int lo = 16 * wg - 8; lo = lo < 0 ? 0 : (lo > 48 ? 48 : lo); int hi = 16 * wg + 7; hi = (hi < 0 ? 0 : (hi > 48 ? 48 : hi)) + 15; na_lo = lo; na_hi = hi; }
    u32x4 kreg[KPT], vreg[VPT];
    auto issue = [&](int t) {
        const bool s1 = t >= T0;
        const int tt = s1 ? t - T0 : t;
        const bf16_t* k0p = s1 ? a.k[1][0] : a.k[0][0];
        const bf16_t* k1p = s1 ? a.k[1][1] : a.k[0][1];
        const bf16_t* vp = s1 ? a.v[1] : a.v[0];
        const int ldk = s1 ? a.ldk[1] : a.ldk[0], ldv = s1 ? a.ldv[1] : a.ldv[0];
#pragma unroll
        for (int i = 0; i < KPT; ++i) {
            const int idx = ltid + NTH * i, mp = idx / (TK * KCH), rem = idx % (TK * KCH), row = rem / KCH, ch = rem % KCH;
            kreg[i] = *(const u32x4*)((NMAP == 2 && mp ? k1p : k0p) + (size_t)(tt * TK + row) * ldk + ch * 8);
        }
#pragma unroll
        for (int i = 0; i < VPT; ++i) {
            const int idx = ltid + NTH * i, row = idx >> 4, ch = idx & 15;
            vreg[i] = *(const u32x4*)(vp + (size_t)(tt * TK + row) * ldv + ch * 8);
        }
    };
    auto stash = [&](int buf) {
        char* Kb = lds + buf * BUFSZ; char* Vb = Kb + NMAP * TK * KSTR;
#pragma unroll
        for (int i = 0; i < KPT; ++i) {
            const int idx = ltid + NTH * i, mp = idx / (TK * KCH), rem = idx % (TK * KCH), row = rem / KCH, ch = rem % KCH;
            *(u32x4*)(Kb + (mp * TK + row) * KSTR + ((ch ^ (DQK == 64 ? ((row >> 1) & 7) : (row & 15))) * 16)) = kreg[i];
        }
#pragma unroll
        for (int i = 0; i < VPT; ++i) {
            const int idx = ltid + NTH * i, row = idx >> 4, ch = idx & 15;
            *(u32x4*)(Vb + row * VSTR + ch * 16) = vreg[i];
        }
    };
    const bool defer = DB && (ltid >> 8) != 0;
    const char* VB_ = Vt; const char* Vprev = Vt;
    bf16x8 Pf[NMAP][2];
            const int qq = (lane & 15) >> 2, pp = lane & 3;
            bf16x8 vfp[2][2][2];
#define VREAD(buf, cb) _Pragma("unroll") for (int c2 = 0; c2 < 2; ++c2) _Pragma("unroll") for (int ks = 0; ks < 2; ++ks) { \
                const char* base = VB_ + (32 * ks + 4 * fq + qq) * VSTR + (16 * ((cb) * 2 + c2) + 4 * pp) * 2; \
                const s16x4 v0 = __builtin_amdgcn_ds_read_tr16_b64_v4i16((LAS s16x4*)base); \
                const s16x4 v1 = __builtin_amdgcn_ds_read_tr16_b64_v4i16((LAS s16x4*)(base + 16 * VSTR)); \
                vfp[buf][c2][ks] = __builtin_shufflevector(v0, v1, 0, 1, 2, 3, 4, 5, 6, 7); }
#if PROBE_DUP == 40
#define VMMA(buf, cb) _Pragma("unroll") for (int c2 = 0; c2 < 2; ++c2) _Pragma("unroll") for (int ks = 0; ks < 2; ++ks) _Pragma("unroll") for (int mp = 0; mp < NMAP; ++mp) { \
                O[mp][(cb) * 2 + c2] = __builtin_amdgcn_mfma_f32_16x16x32_bf16(vfp[buf][c2][ks], Pf[mp][ks], O[mp][(cb) * 2 + c2], 0, 0, 0); \
                O[mp][(cb) * 2 + c2] = __builtin_amdgcn_mfma_f32_16x16x32_bf16(vfp[buf][c2][ks], Pf[mp][ks], O[mp][(cb) * 2 + c2], 0, 0, 0); }
#else
#define VMMA(buf, cb) _Pragma("unroll") for (int c2 = 0; c2 < 2; ++c2) _Pragma("unroll") for (int ks = 0; ks < 2; ++ks) _Pragma("unroll") for (int mp = 0; mp < NMAP; ++mp) \
                O[mp][(cb) * 2 + c2] = __builtin_amdgcn_mfma_f32_16x16x32_bf16(vfp[buf][c2][ks], Pf[mp][ks], O[mp][(cb) * 2 + c2], 0, 0, 0);
#endif
#define PV_REST __builtin_amdgcn_sched_barrier(0); VREAD(1, 1) __builtin_amdgcn_sched_barrier(0); VMMA(0, 0) __builtin_amdgcn_sched_barrier(0); VREAD(0, 2) \
                __builtin_amdgcn_sched_barrier(0); VMMA(1, 1) __builtin_amdgcn_sched_barrier(0); VREAD(1, 3) __builtin_amdgcn_sched_barrier(0); VMMA(0, 2) VMMA(1, 3)
    issue(0);
    if (DB) { stash(0); __syncthreads(); if (1 < T) issue(1); }
    int bcur = 0;
    for (int t = 0; t < T; ++t) {
        if (!DB) {
            __syncthreads();
            stash(0);
            __syncthreads();
            if (t + 1 < T) issue(t + 1);
        } else {
            Kt = lds + bcur * BUFSZ; Vt = Kt + NMAP * TK * KSTR;
        }

        const bool masked = NA && t < T0;
#pragma unroll
        for (int sub = 0; sub < NSUB; ++sub) {
            const char* Ks = Kt + sub * 64 * KSTR;
            const char* Vs = Vt + sub * 64 * VSTR;
            if (defer && t > 0) { VB_ = Vprev; VREAD(0, 0) PV_REST __builtin_amdgcn_sched_barrier(0); }
            f32x4 S[NMAP][4];
#pragma unroll
            for (int mp = 0; mp < NMAP; ++mp) {
                bf16x8 kfr[4][NS_];
#pragma unroll
                for (int kt = 0; kt < 4; ++kt)
#pragma unroll
                    for (int s = 0; s < NS_; ++s)
                        kfr[kt][s] = *(const bf16x8*)(Ks + (mp * TK + 16 * kt + fr) * KSTR + (((4 * s + fq) ^ (DQK == 64 ? (fr >> 1) : fr)) * 16));
                __builtin_amdgcn_sched_barrier(0);
#pragma unroll
                for (int kt = 0; kt < 4; ++kt) {
                    f32x4 sacc = (f32x4){0.f, 0.f, 0.f, 0.f};
                    const bool live = !masked || (16 * kt + 15 >= na_lo && 16 * kt <= na_hi);
                    if (live) {
#pragma unroll
                        for (int s = 0; s < NS_; ++s) sacc = __builtin_amdgcn_mfma_f32_16x16x32_bf16(kfr[kt][s], Qf[mp][s], sacc, 0, 0, 0);
                    }
                    S[mp][kt] = sacc;
                }
            }
            if (!defer) { VB_ = Vs; VREAD(0, 0) }
            __builtin_amdgcn_sched_barrier(0);
#pragma unroll
            for (int mp = 0; mp < NMAP; ++mp) {
                float tmax = -1e30f;
                if (NA && masked) {
#pragma unroll
                    for (int kt = 0; kt < 4; ++kt)
#pragma unroll
                        for (int j = 0; j < 4; ++j) {
                            const int cc = 16 * kt + 4 * fq + j, c = wg * 16 + fr;
                            int cs = c - 8; cs = cs < 0 ? 0 : (cs > 48 ? 48 : cs);
                            const bool ok = (cc >= cs) && (cc < cs + 16);
                            const int dr = a.r0 + t - a.r + 7, dc = cc - c + 15;
                            const float sv = ok ? S[mp][kt][j] * a.scale_l2 + rpbl[dr * 31 + (ok ? dc : 0)] : -__builtin_inff();
                            S[mp][kt][j] = sv;
                            tmax = fmaxf(tmax, sv);
                        }
                } else {
                    float rmax = -1e30f;
#pragma unroll
                    for (int kt = 0; kt < 4; ++kt) rmax = fmaxf(rmax, fmaxf(fmaxf(S[mp][kt][0], S[mp][kt][1]), fmaxf(S[mp][kt][2], S[mp][kt][3])));
                    tmax = rmax * a.scale_l2;
                }
                tmax = fmaxf(tmax, __shfl_xor(tmax, 16));
                tmax = fmaxf(tmax, __shfl_xor(tmax, 32));
                const bool rebase = !__all(tmax - mrun[mp] <= 8.0f);
                const float mnew = rebase ? fmaxf(mrun[mp], tmax) : mrun[mp];
                const float alpha = rebase ? __builtin_amdgcn_exp2f(mrun[mp] - mnew) : 1.0f;
                mrun[mp] = mnew;
                float ls = 0.f;
                if (NA && masked) {
#pragma unroll
                    for (int kt = 0; kt < 4; ++kt)
#pragma unroll
                        for (int j = 0; j < 4; ++j) { const float pe = __builtin_amdgcn_exp2f(S[mp][kt][j] - mnew); S[mp][kt][j] = pe; ls += pe; }
                } else {
#pragma unroll
                    for (int kt = 0; kt < 4; ++kt)
#pragma unroll
#if PROBE_DUP == 41
                        for (int j = 0; j < 4; ++j) { float xin = __builtin_fmaf(S[mp][kt][j], a.scale_l2, -mnew); const float pe = __builtin_amdgcn_exp2f(xin); asm volatile("" : "+v"(xin));
                            const float pe2 = __builtin_amdgcn_exp2f(xin); const float pe3 = __builtin_amdgcn_exp2f(xin * 0.5f); S[mp][kt][j] = pe; ls += pe + 0.0f * (pe2 + pe3); }
#else
                        for (int j = 0; j < 4; ++j) { const float pe = __builtin_amdgcn_exp2f(__builtin_fmaf(S[mp][kt][j], a.scale_l2, -mnew)); S[mp][kt][j] = pe; ls += pe; }
#endif
                }
                lrun[mp] = lrun[mp] * alpha + ls;
                if (rebase) {
#pragma unroll
                    for (int c = 0; c < 8; ++c) O[mp][c] *= alpha;
                }
#pragma unroll
                for (int ks = 0; ks < 2; ++ks) {
                    u32x4 w;
#if PROBE_DUP == 40
#define PH_ 0.5f *
#else
#define PH_
#endif
                    w[0] = pack_bf2(PH_ S[mp][2 * ks][0], PH_ S[mp][2 * ks][1]); w[1] = pack_bf2(PH_ S[mp][2 * ks][2], PH_ S[mp][2 * ks][3]);
                    w[2] = pack_bf2(PH_ S[mp][2 * ks + 1][0], PH_ S[mp][2 * ks + 1][1]); w[3] = pack_bf2(PH_ S[mp][2 * ks + 1][2], PH_ S[mp][2 * ks + 1][3]);
#undef PH_
                    Pf[mp][ks] = *(bf16x8*)&w;
                }
            }
            if (!defer) { PV_REST }
            Vprev = Vs;
        }
        if (DB) {
            const int bnext = bcur == 2 ? 0 : bcur + 1;
            if (t + 1 < T) stash(bnext);
            __syncthreads();
            if (t + 2 < T) issue(t + 2);
            bcur = bnext;
        }
    }
    if (defer) { VB_ = Vprev; VREAD(0, 0) PV_REST }
#undef PV_REST
#undef VREAD
#undef VMMA
    float inv[NMAP];
#pragma unroll
    for (int mp = 0; mp < NMAP; ++mp) {
        float l = lrun[mp]; l += __shfl_xor(l, 16); l += __shfl_xor(l, 32); inv[mp] = 1.0f / l;
    }
    bf16_t* orow = a.o + (size_t)(wg * 16 + fr) * D;
    if (NMAP == 1) {
#pragma unroll
        for (int c = 0; c < 8; ++c) {
            const f32x4 v = O[0][c] * inv[0];
            u32x2 o; o[0] = pack_bf2(v[0], v[1]); o[1] = pack_bf2(v[2], v[3]);
            *(u32x2*)(orow + 16 * c + 4 * fq) = o;
        }
    } else {
        f32x4 d[8]; float ss = 0.f;
#pragma unroll
        for (int c = 0; c < 8; ++c) {
            d[c] = O[0][c] * inv[0] - a.lam * (O[NMAP - 1][c] * inv[NMAP - 1]);
            ss += d[c][0] * d[c][0] + d[c][1] * d[c][1] + d[c][2] * d[c][2] + d[c][3] * d[c][3];
        }
        ss += __shfl_xor(ss, 16); ss += __shfl_xor(ss, 32);
        const float rn = rsqrtf(ss * (1.0f / 128.0f) + 1e-6f) * a.oml;
#pragma unroll
        for (int c = 0; c < 8; ++c) {
            const f32x4 g = *(const f32x4*)(a.subg + 16 * c + 4 * fq);
            const f32x4 v = d[c] * rn * g;
            u32x2 o; o[0] = pack_bf2(v[0], v[1]); o[1] = pack_bf2(v[2], v[3]);
            *(u32x2*)(orow + 16 * c + 4 * fq) = o;
        }
    }
    __syncthreads();
}

__device__ __forceinline__ void sg_unit(const Params& p, int l, int chunk, int g, char* smem, int tid) {
    constexpr int TSTR = 272;
    char* vnT = smem;
    float* stat = (float*)(smem + 128 * TSTR);
    const int t = tid, lane = t & 63, wid = t >> 6, fr = lane & 15, fq = lane >> 4;
    const int row0 = chunk * 128;
    {
        const int tok = t >> 2, part = t & 3;
        const bf16_t* vp = p.P() + (size_t)(row0 + tok) * INW + C_V + part * 128;
        float s = 0.f, q = 0.f;
#pragma unroll
        for (int i = 0; i < 16; ++i) {
            const u32x4 w = *(const u32x4*)(vp + i * 8);
#pragma unroll
            for (int j = 0; j < 4; ++j) { const float a = bf_lo(w[j]), b = bf_hi(w[j]); s += a + b; q += a * a + b * b; }
        }
        s += __shfl_xor(s, 1); s += __shfl_xor(s, 2); q += __shfl_xor(q, 1); q += __shfl_xor(q, 2);
        const float mean = s * (1.0f / 512.0f);
        const float var = fmaxf(q * (1.0f / 512.0f) - mean * mean, 0.f);
        if (part == 0) { stat[tok * 2] = mean; stat[tok * 2 + 1] = rsqrtf(var + 1e-5f); }
    }
    __syncthreads();
    {
        const int q = t & 127, part = t >> 7;
        const float mean = stat[q * 2], rstd = stat[q * 2 + 1];
        const bf16_t* vp = p.P() + (size_t)(row0 + q) * INW + C_V + g * 128 + part * 32;
        const float* lg = p.vec() + V_SGLNG + (size_t)l * 512 + g * 128 + part * 32;
        const float* lb = p.vec() + V_SGLNB + (size_t)l * 512 + g * 128 + part * 32;
#pragma unroll
        for (int i = 0; i < 4; ++i) {
            const u32x4 w = *(const u32x4*)(vp + i * 8);
#pragma unroll
            for (int j = 0; j < 4; ++j) {
                const int c = part * 32 + i * 8 + 2 * j;
                const float a = (bf_lo(w[j]) - mean) * rstd * lg[i * 8 + 2 * j] + lb[i * 8 + 2 * j];
                const float b = (bf_hi(w[j]) - mean) * rstd * lg[i * 8 + 2 * j + 1] + lb[i * 8 + 2 * j + 1];
                const unsigned pk = pack_bf2(a, b);
                *(bf16_t*)(vnT + c * TSTR + q * 2) = (bf16_t)(pk & 0xffff);
                *(bf16_t*)(vnT + (c + 1) * TSTR + q * 2) = (bf16_t)(pk >> 16);
            }
        }
    }
    __syncthreads();
    {
        bf16x8 Af[4];
#pragma unroll
        for (int s = 0; s < 4; ++s) Af[s] = *(const bf16x8*)(vnT + (16 * wid + fr) * TSTR + (32 * s + 8 * fq) * 2);
        const bf16_t* ws = p.sgwB() + ((size_t)l * 4 + g) * 128 * 128;
#pragma unroll
        for (int pt = 0; pt < 8; ++pt) {
            f32x4 acc = (f32x4){0.f, 0.f, 0.f, 0.f};
#pragma unroll
            for (int s = 0; s < 4; ++s) {
                const bf16x8 bfr = *(const bf16x8*)(ws + (size_t)(16 * pt + fr) * 128 + 32 * s + 8 * fq);
                acc = __builtin_amdgcn_mfma_f32_16x16x32_bf16(Af[s], bfr, acc, 0, 0, 0);
            }
            const int pos = 16 * pt + fr, c = 16 * wid + 4 * fq;
            const float bias = p.vec()[V_SGB + ((size_t)l * 4 + g) * 128 + pos];
            const bf16_t* up = p.P() + (size_t)(row0 + pos) * INW + C_U + g * 128 + c;
            const u32x2 uw = *(const u32x2*)up;
            u32x2 o;
            o[0] = pack_bf2(bf_lo(uw[0]) * (acc[0] + bias), bf_hi(uw[0]) * (acc[1] + bias));
            o[1] = pack_bf2(bf_lo(uw[1]) * (acc[2] + bias), bf_hi(uw[1]) * (acc[3] + bias));
            *(u32x2*)(p.MIX() + (size_t)(row0 + pos) * D + 1024 + g * 128 + c) = o;
        }
    }
    __syncthreads();
}

__device__ __forceinline__ void phase_mixers(const Params& p0, int l, char* smem, int tid0) {
    constexpr int U_CL = 256, U_NA = 512, U_AC = 256, U_CC = 128, U_SG = 384;
#if PROBE_DUP >= 10
    constexpr int PLO = PROBE_DUP == 10 ? 0 : (PROBE_DUP == 11 ? U_CL : (PROBE_DUP == 12 ? U_CL + U_NA : U_CL + U_NA + U_AC + U_CC));
    constexpr int PHI = PROBE_DUP == 10 ? U_CL : (PROBE_DUP == 11 ? U_CL + U_NA : (PROBE_DUP == 12 ? U_CL + U_NA + U_AC + U_CC : U_CL + U_NA + U_AC + U_CC + U_SG));
#pragma unroll 1
    for (int rep = 0; rep < 2; ++rep)
    for (int u = (rep ? PLO : 0) + blockIdx.x; u < (rep ? PHI : U_CL + U_NA + U_AC + U_CC + U_SG); u += gridDim.x) {
#else
    for (int u = blockIdx.x; u < U_CL + U_NA + U_AC + U_CC + U_SG; u += gridDim.x) {
#endif
        Params p = p0; int tid = tid0; asm volatile("" : "+s"(p.ws), "+v"(tid));
        const int t = tid, grp = t >> 8, gtid = t & 255;
        char* glds = smem + grp * ATT_GROUP_LDS;
        const float lam = p.lam()[l], oml = 1.0f - lam_init_of(l);
        if (u >= U_CL + U_NA + U_AC + U_CC) { const int v = u - (U_CL + U_NA + U_AC + U_CC); sg_unit(p, l, v >> 2, v & 3, smem, tid); continue; }
        AttnArgs a;
        a.rpb = nullptr; a.r = 0; a.r0 = 0; a.lam = lam; a.oml = oml; a.subg = p.vec() + V_SUBG + (size_t)l * 128;
        a.q[1] = nullptr; a.k[0][1] = nullptr; a.k[1][0] = nullptr; a.k[1][1] = nullptr; a.v[1] = nullptr;
        a.ldk[1] = 0; a.ldv[1] = 0; a.nt[1] = 0; a.ldq = INW; a.ldk[0] = INW; a.ldv[0] = INW;
        if (u < U_CL || u >= U_CL + U_NA + U_AC) {
            const bool lat = u < U_CL;
            int b, h, qc; size_t rb;
            if (lat) { b = u >> 7; h = (u >> 5) & 3; qc = (u & 31) * 2 + grp; rb = (size_t)NP + (size_t)b * 4096; }
            else { const int v = u - (U_CL + U_NA + U_AC); b = v >> 3; h = (v >> 1) & 3; qc = (v & 1) * 2 + grp; rb = (size_t)b * 256; }
            const bf16_t* Pb = p.P() + rb * INW;
            a.q[0] = Pb + (size_t)(qc * 64) * INW + C_Q1 + h * 64; a.q[1] = Pb + (size_t)(qc * 64) * INW + C_Q2 + h * 64;
            a.k[0][0] = Pb + C_K1 + h * 64; a.k[0][1] = Pb + C_K2 + h * 64; a.v[0] = Pb + C_VC + h * 128; a.nt[0] = lat ? 64 : 4;
            if (lat) {
                const size_t cb = ((size_t)(b * DEPTH + l) * 4 + h) * 256;
                a.k[1][0] = p.cdk1() + cb * 64; a.k[1][1] = p.cdk2() + cb * 64; a.v[1] = p.cdv() + cb * 128; a.ldk[1] = 64; a.ldv[1] = 128; a.nt[1] = 4;
            }
            a.o = p.MIX() + (rb + (size_t)qc * 64) * D + 1536 + h * 128;
            a.scale_l2 = 0.125f * LOG2E;
            attn_group<2, 64, false, true>(a, smem, gtid, t);
        } else if (u < U_CL + U_NA) {
            const int v = u - U_CL, b = v >> 8, hp = (v >> 6) & 3, r = v & 63, h = hp * 2 + grp;
            int r0 = r - 4; r0 = r0 < 0 ? 0 : (r0 > 56 ? 56 : r0);
            const size_t rb = (size_t)NP + (size_t)b * 4096;
            const bf16_t* Pb = p.P() + rb * INW;
            a.q[0] = Pb + (size_t)(r * 64) * INW + C_QA + h * 128;
            a.k[0][0] = Pb + (size_t)(r0 * 64) * INW + C_KA + h * 128; a.v[0] = Pb + (size_t)(r0 * 64) * INW + C_VA + h * 128; a.nt[0] = 8;
            const size_t cb = ((size_t)(b * DEPTH + l) * 8 + h) * 256 * 128;
            a.k[1][0] = p.cnak() + cb; a.v[1] = p.cnav() + cb; a.ldk[1] = 128; a.ldv[1] = 128; a.nt[1] = 4;
            a.o = p.MIX() + (rb + (size_t)r * 64) * D + h * 128;
            a.scale_l2 = 0.08838834764831845f * LOG2E;
            a.rpb = p.vec() + V_RPB + ((size_t)l * 8 + h) * 465; a.r = r; a.r0 = r0;
            attn_group<1, 128, true, false>(a, glds, gtid, gtid);
        } else {
            const int v = u - U_CL - U_NA, b = v >> 4, h = (v >> 1) & 7, qc = (v & 1) * 2 + grp;
            const bf16_t* Pb = p.P() + (size_t)(b * 256) * INW;
            a.q[0] = Pb + (size_t)(qc * 64) * INW + C_QA + h * 128;
            a.k[0][0] = Pb + C_KA + h * 128; a.v[0] = Pb + C_VA + h * 128; a.nt[0] = 4;
            a.o = p.MIX() + (size_t)(b * 256 + qc * 64) * D + h * 128;
            a.scale_l2 = 0.08838834764831845f * LOG2E;
            attn_group<1, 128, false, true>(a, smem, gtid, t);
        }
    }
}

template <int CTRL> __device__ __forceinline__ int dpp_i(int v) { return __builtin_amdgcn_update_dpp(0, v, CTRL, 0xf, 0xf, true); }
__device__ __forceinline__ int imax(int a, int b) { return a > b ? a : b; }
__device__ __forceinline__ int f2ord(float f) { const int b = __float_as_int(f); return b ^ ((b >> 31) & 0x7fffffff); }
__device__ __forceinline__ float ord2f(int o) { return __int_as_float(o ^ ((o >> 31) & 0x7fffffff)); }

constexpr int PL_SCR1 = 16384, PL_LIST = 32768, PL_LIST_BYTES = 16384;

__device__ __forceinline__ void select_scores_topk(const Params& p, int l, int row0, int h, int ha, int hh_slot, float* tkv, int* tki, int fr, int fq) {
    bf16x8 Qf[4];
#pragma unroll
    for (int s = 0; s < 4; ++s) Qf[s] = *(const bf16x8*)(p.Qp() + (size_t)(row0 + fr) * D + h * 256 + ha * 128 + 32 * s + 8 * fq);
    const bf16_t* kb = p.keysB() + (((size_t)l * 8 + h) * 2 + ha) * 128 * 128;
    int pk[4][8];
#pragma unroll
    for (int nt = 0; nt < 8; ++nt) {
        f32x4 acc = (f32x4){0.f, 0.f, 0.f, 0.f};
#pragma unroll
        for (int s = 0; s < 4; ++s) {
            const bf16x8 kf = *(const bf16x8*)(kb + (size_t)(16 * nt + fr) * 128 + 32 * s + 8 * fq);
            acc = __builtin_amdgcn_mfma_f32_16x16x32_bf16(Qf[s], kf, acc, 0, 0, 0);
        }
#pragma unroll
        for (int j = 0; j < 4; ++j) pk[j][nt] = (f2ord(acc[j]) & ~127) | (127 - (16 * nt + fr));
    }
#pragma unroll 1
    for (int rd = 0; rd < 16; ++rd) {
#pragma unroll
        for (int j = 0; j < 4; ++j) {
            int m = imax(imax(imax(pk[j][0], pk[j][1]), imax(pk[j][2], pk[j][3])), imax(imax(pk[j][4], pk[j][5]), imax(pk[j][6], pk[j][7])));
            m = imax(m, dpp_i<0xB1>(m)); m = imax(m, dpp_i<0x4E>(m)); m = imax(m, dpp_i<0x141>(m)); m = imax(m, dpp_i<0x140>(m));
#pragma unroll
            for (int nt = 0; nt < 8; ++nt) pk[j][nt] = pk[j][nt] == m ? (int)0x80000000 : pk[j][nt];
            if (fr == 0) {
                const int tok = 4 * fq + j;
                tkv[((tok * 4 + hh_slot) * 2 + ha) * 16 + rd] = ord2f(m & ~127);
                tki[((tok * 4 + hh_slot) * 2 + ha) * 16 + rd] = 127 - (m & 127);
            }
        }
    }
}
__device__ __forceinline__ void staircase_cells(int sub, int (&cell)[7]) {
#pragma unroll
    for (int m = 0; m < 7; ++m) {
        const int n = sub + 8 * m;
        int i = 0, base = 0; bool go = true;
#pragma unroll
        for (int ii = 0; ii < 16; ++ii) { const int cnt = 16 / (ii + 1); go = go && (n >= base + cnt); if (go) { base += cnt; i = ii + 1; } }
        cell[m] = n < 50 ? i * 16 + (n - base) : -1;
    }
}
__device__ __forceinline__ void select_stage2(int tok, int h2, int sub, const int (&cell)[7], const float* tkv, const int* tki, int* idl, float* gl, int hq) {
    const float* v0 = tkv + ((tok * 4 + h2) * 2 + 0) * 16; const float* v1 = tkv + ((tok * 4 + h2) * 2 + 1) * 16;
    const int* i0 = tki + ((tok * 4 + h2) * 2 + 0) * 16;   const int* i1 = tki + ((tok * 4 + h2) * 2 + 1) * 16;
    int cp[7];
#pragma unroll
    for (int m = 0; m < 7; ++m) {
        const bool ok = cell[m] >= 0;
        const int c = ok ? cell[m] : 0;
        const float cv = v0[c >> 4] + v1[c & 15];
        cp[m] = ok ? ((f2ord(cv) & ~255) | (255 - c)) : (int)0x80000000;
    }
    int bidx[16];
#pragma unroll
    for (int rd = 0; rd < 16; ++rd) {
        int m = imax(imax(imax(cp[0], cp[1]), imax(cp[2], cp[3])), imax(imax(cp[4], cp[5]), cp[6]));
        m = imax(m, dpp_i<0xB1>(m)); m = imax(m, dpp_i<0x4E>(m)); m = imax(m, dpp_i<0x141>(m));
#pragma unroll
        for (int q = 0; q < 7; ++q) cp[q] = cp[q] == m ? (int)0x80000000 : cp[q];
        bidx[rd] = 255 - (m & 255);
    }
    if (sub == 0) {
        float best[16], e[16], sum = 0.f;
#pragma unroll
        for (int rd = 0; rd < 16; ++rd) best[rd] = v0[bidx[rd] >> 4] + v1[bidx[rd] & 15];
#pragma unroll
        for (int rd = 0; rd < 16; ++rd) { e[rd] = __expf(best[rd] - best[0]); sum += e[rd]; }
        const float inv = 1.0f / sum;
        const int ob = tok * 128 + (hq * 4 + h2) * 16;
#pragma unroll
        for (int rd = 0; rd < 16; ++rd) {
            const int c = bidx[rd];
            idl[ob + rd] = i0[c >> 4] * 128 + i1[c & 15];
            gl[ob + rd] = e[rd] * inv;
        }
    }
}
template <int NH>
__device__ __forceinline__ void select_wave(const Params& p, int l, char* scr, int lane, int tb, int hq, int hs0, char* list) {
    const int fr = lane & 15, fq = lane >> 4;
    float* tkv = (float*)scr; int* tki = (int*)(scr + 8192);
#pragma unroll 1
    for (int hw = 0; hw < 2 * NH; ++hw) select_scores_topk(p, l, tb * 16, hq * 4 + hs0 + (hw >> 1), hw & 1, hs0 + (hw >> 1), tkv, tki, fr, fq);
    asm volatile("s_waitcnt lgkmcnt(0)" ::: "memory");
    int cell[7]; staircase_cells(lane & 7, cell);
#pragma unroll 1
    for (int ps = 0; ps < 2 * NH; ++ps) {
        const int pr = ps * 8 + (lane >> 3);
        select_stage2(NH == 1 ? pr : pr >> 1, hs0 + (NH == 1 ? 0 : (pr & 1)), lane & 7, cell, tkv, tki, (int*)list, (float*)(list + 8192), hq);
    }
}

typedef int v8i_t __attribute__((ext_vector_type(8)));
constexpr int PW_SCR = 65536, PW_STRIDE = 5632;
__device__ __forceinline__ void apply_token(const Params& p, int l, int lane, int r, const int* idl, const int id0, const int id1, const float g0, const float g1, char* wscr) {
    const unsigned char* Ul = p.Ub() + (size_t)l * NEXP * ROW4;
    const unsigned char* Vl = p.Vb() + (size_t)l * NEXP * ROW4;
    {
        const int fr = lane & 15, fq = lane >> 4;
        {
            float rr[32];
#pragma unroll
            for (int v = 0; v < 4; ++v) {
                const u32x4 q = *(const u32x4*)(p.H() + (size_t)r * D + lane * 32 + 8 * v);
#pragma unroll
                for (int j = 0; j < 4; ++j) { rr[8 * v + 2 * j] = 0.25f * bf_lo(q[j]); rr[8 * v + 2 * j + 1] = 0.25f * bf_hi(q[j]); }
            }
#pragma unroll
            for (int lv = 0; lv < 4; ++lv) {
                u32x4 o;
#pragma unroll
                for (int w = 0; w < 4; ++w) {
                    unsigned pk = 0;
                    pk = __builtin_amdgcn_cvt_scalef32_pk_fp4_f32(pk, rr[8 * w], rr[8 * w + 1], 1.0f, 0);
                    pk = __builtin_amdgcn_cvt_scalef32_pk_fp4_f32(pk, rr[8 * w + 2], rr[8 * w + 3], 1.0f, 1);
                    pk = __builtin_amdgcn_cvt_scalef32_pk_fp4_f32(pk, rr[8 * w + 4], rr[8 * w + 5], 1.0f, 2);
                    pk = __builtin_amdgcn_cvt_scalef32_pk_fp4_f32(pk, rr[8 * w + 6], rr[8 * w + 7], 1.0f, 3);
                    o[w] = pk;
                    if (lv < 3) {
                        const f32x2 d0 = __builtin_amdgcn_cvt_scalef32_pk_f32_fp4(pk, 1.0f, 0), d1 = __builtin_amdgcn_cvt_scalef32_pk_f32_fp4(pk, 1.0f, 1);
                        const f32x2 d2 = __builtin_amdgcn_cvt_scalef32_pk_f32_fp4(pk, 1.0f, 2), d3 = __builtin_amdgcn_cvt_scalef32_pk_f32_fp4(pk, 1.0f, 3);
                        rr[8 * w] = 4.0f * (rr[8 * w] - d0[0]); rr[8 * w + 1] = 4.0f * (rr[8 * w + 1] - d0[1]);
                        rr[8 * w + 2] = 4.0f * (rr[8 * w + 2] - d1[0]); rr[8 * w + 3] = 4.0f * (rr[8 * w + 3] - d1[1]);
                        rr[8 * w + 4] = 4.0f * (rr[8 * w + 4] - d2[0]); rr[8 * w + 5] = 4.0f * (rr[8 * w + 5] - d2[1]);
                        rr[8 * w + 6] = 4.0f * (rr[8 * w + 6] - d3[0]); rr[8 * w + 7] = 4.0f * (rr[8 * w + 7] - d3[1]);
                    }
                }
                *(u32x4*)(wscr + lv * 1024 + lane * 16) = o;
            }
        }
        __builtin_amdgcn_wave_barrier();
        const unsigned char* rowp[8];
#pragma unroll
        for (int T = 0; T < 8; ++T) rowp[T] = Ul + (size_t)idl[T * 16 + fr] * ROW4 + fq * 16;
        const char* bsrc = wscr + (fr & 3) * 1024 + fq * 16;
        const int sa = 0x7F7F7F7F, sb = 0x7F7F7F7F;
        f32x4 acc[8];
#pragma unroll
        for (int T = 0; T < 8; ++T) acc[T] = (f32x4){0.f, 0.f, 0.f, 0.f};
        u32x4 A[3][4][2];
#pragma unroll
        for (int st = 0; st < 2; ++st)
#pragma unroll
            for (int tt = 0; tt < 4; ++tt)
#pragma unroll
                for (int kk = 0; kk < 2; ++kk) A[st][tt][kk] = *(const u32x4*)(rowp[4 * (st & 1) + tt] + (st >> 1) * 128 + kk * 64);
        v8i_t B[2];
        u32x4 VA[8][4];
        const unsigned char* vbase = Vl + fr * 16;
        const int* idp = idl + fq * 32;
        const u32x4 i0 = *(const u32x4*)idp, i1 = *(const u32x4*)(idp + 4);
#pragma unroll
        for (int st = 0; st < 16; ++st) {
            if (st == 14) {
#pragma unroll
                for (int vs = 0; vs < 4; ++vs)
#pragma unroll
                    for (int q = 0; q < 4; ++q) VA[vs][q] = *(const u32x4*)(vbase + (size_t)i0[vs] * ROW4 + q * 256);
            }
            if (st + 2 < 16) {
                const int s2 = st + 2;
#pragma unroll
                for (int tt = 0; tt < 4; ++tt)
#pragma unroll
                    for (int kk = 0; kk < 2; ++kk) A[s2 % 3][tt][kk] = *(const u32x4*)(rowp[4 * (s2 & 1) + tt] + (s2 >> 1) * 128 + kk * 64);
            }
            if ((st & 1) == 0) {
#pragma unroll
                for (int kk = 0; kk < 2; ++kk) {
                    const u32x4 b0 = *(const u32x4*)(bsrc + (st + kk) * 64);
                    B[kk] = (v8i_t){(int)b0[0], (int)b0[1], (int)b0[2], (int)b0[3], 0, 0, 0, 0};
                }
            }
            __builtin_amdgcn_sched_barrier(0);
#pragma unroll
            for (int tt = 0; tt < 4; ++tt)
#pragma unroll
                for (int kk = 0; kk < 2; ++kk) {
                    const u32x4 a = A[st % 3][tt][kk];
                    const v8i_t av = (v8i_t){(int)a[0], (int)a[1], (int)a[2], (int)a[3], 0, 0, 0, 0};
                    acc[4 * (st & 1) + tt] = __builtin_amdgcn_mfma_scale_f32_16x16x128_f8f6f4(av, B[kk], acc[4 * (st & 1) + tt], 4, 4, 0, sa, 0, sb);
                }
#pragma unroll
            for (int tt = 0; tt < 4; ++tt) asm volatile("" : "+v"(acc[4 * (st & 1) + tt]));
            __builtin_amdgcn_sched_barrier(0);
        }
#pragma unroll
        for (int vs = 4; vs < 7; ++vs)
#pragma unroll
            for (int q = 0; q < 4; ++q) VA[vs][q] = *(const u32x4*)(vbase + (size_t)i1[vs - 4] * ROW4 + q * 256);
        __builtin_amdgcn_sched_barrier(0);
        float* wdot = (float*)(wscr + 4096);
        const float lvs = ((fr & 3) == 0 ? 4.0f : (fr & 3) == 1 ? 1.0f : (fr & 3) == 2 ? 0.25f : 0.0625f) * (1.0f / U_SCALE);
#pragma unroll
        for (int T = 0; T < 8; ++T) {
            f32x4 tot;
#pragma unroll
            for (int j = 0; j < 4; ++j) {
                float t2 = acc[T][j] * lvs;
                t2 += __int_as_float(dpp_i<0xB1>(__float_as_int(t2)));
                t2 += __int_as_float(dpp_i<0x4E>(__float_as_int(t2)));
                tot[j] = t2;
            }
            if (fr == 0) *(f32x4*)(wdot + T * 16 + 4 * fq) = tot;
        }
        __builtin_amdgcn_wave_barrier();
        unsigned* wd = (unsigned*)(wscr + 4608);
        int sexp;
        {
            const float a0 = wdot[lane], a1 = wdot[64 + lane];
            const float w0 = g0 * (0.5f / V_SCALE) * a0 * (1.0f + erff(a0 * 0.70710678118654752f));
            const float w1 = g1 * (0.5f / V_SCALE) * a1 * (1.0f + erff(a1 * 0.70710678118654752f));
            float wm = fmaxf(fabsf(w0), fabsf(w1));
#pragma unroll
            for (int sft = 32; sft >= 1; sft >>= 1) wm = fmaxf(wm, __shfl_xor(wm, sft));
            int ex = (__float_as_int(wm) >> 23) & 0xFF;
            ex = ex < 28 ? 28 : ex;
            sexp = 128 - ex;
            const float S = __int_as_float((255 - ex) << 23);
#pragma unroll
            for (int hb = 0; hb < 2; ++hb) {
                const float r0 = (hb ? w1 : w0) * S;
                const unsigned e0 = __builtin_amdgcn_cvt_scalef32_pk_fp4_f32(0u, r0, 0.0f, 1.0f, 0) & 0xFFu;
                const unsigned o0 = __builtin_amdgcn_cvt_scalef32_pk_fp4_f32(0u, 0.0f, r0, 1.0f, 0) & 0xFFu;
                const f32x2 d0 = __builtin_amdgcn_cvt_scalef32_pk_f32_fp4(e0, 1.0f, 0);
                const float r1 = 4.0f * (r0 - d0[0]);
                const unsigned e1 = __builtin_amdgcn_cvt_scalef32_pk_fp4_f32(0u, r1, 0.0f, 1.0f, 0) & 0xFFu;
                const unsigned o1 = __builtin_amdgcn_cvt_scalef32_pk_fp4_f32(0u, 0.0f, r1, 1.0f, 0) & 0xFFu;
                wd[hb * 64 + lane] = e0 | (e1 << 8);
                wd[128 + hb * 64 + lane] = o0 | (o1 << 8);
            }
        }
        __builtin_amdgcn_wave_barrier();
        const int vsa = 127 * 0x01010101;
        const int vsb0 = (int)((unsigned)(127 - sexp) * 0x01010101u), vsb1 = (int)((unsigned)(127 - 2 - sexp) * 0x01010101u);
        const int bsh = 8 * ((fr >> 1) & 3);
        const bool blo = fr < 8;
        const unsigned* wdp = wd + (fr & 1) * 128 + fq * 32;
        f32x4 ya[8];
#pragma unroll
        for (int c = 0; c < 8; ++c) ya[c] = (f32x4){0.f, 0.f, 0.f, 0.f};
        {
            int idn = (int)i1[3];
#pragma unroll 1
            for (int G0 = 0; G0 < 32; G0 += 8) {
                const u32x4 xsA = *(const u32x4*)(wdp + G0), xsB = *(const u32x4*)(wdp + G0 + 4);
#pragma unroll
                for (int st = 0; st < 8; ++st) {
                    if (G0 + st + 7 < 32) {
#pragma unroll
                        for (int q = 0; q < 4; ++q) VA[(st + 7) & 7][q] = *(const u32x4*)(vbase + (size_t)idn * ROW4 + q * 256);
                    }
                    idn = idp[(G0 + st + 8) & 31];
                    __builtin_amdgcn_sched_barrier(0);
                    const unsigned xw = st < 4 ? xsA[st & 3] : xsB[st & 3];
#pragma unroll
                    for (int dg = 0; dg < 2; ++dg) {
                        const unsigned val = ((xw >> (8 * dg)) & 0xFFu) << bsh;
                        const int c0 = blo ? (int)val : 0, c1 = blo ? 0 : (int)val;
                        const v8i_t B0 = (v8i_t){c0, c1, 0, 0, 0, 0, 0, 0}, B1 = (v8i_t){0, 0, c0, c1, 0, 0, 0, 0};
#pragma unroll
                        for (int q = 0; q < 4; ++q) {
                            const u32x4 a = VA[st][q];
                            const v8i_t av = (v8i_t){(int)a[0], (int)a[1], (int)a[2], (int)a[3], 0, 0, 0, 0};
                            ya[2 * q] = __builtin_amdgcn_mfma_scale_f32_16x16x128_f8f6f4(av, B0, ya[2 * q], 4, 4, 0, vsa, 0, dg ? vsb1 : vsb0);
                            ya[2 * q + 1] = __builtin_amdgcn_mfma_scale_f32_16x16x128_f8f6f4(av, B1, ya[2 * q + 1], 4, 4, 0, vsa, 0, dg ? vsb1 : vsb0);
                        }
                    }
#pragma unroll
                    for (int c = 0; c < 8; ++c) asm volatile("" : "+v"(ya[c]));
                    __builtin_amdgcn_sched_barrier(0);
                }
            }
        }
        const int cnd = cond_of_row(r);
        const bool last = (l == DEPTH - 1);
        float* xo = last ? (r < NP ? p.outp() + O_YP + (size_t)r * D : p.outp() + O_YS + (size_t)(r - NP) * D) : p.X() + (size_t)r * D;
        const int ln = last ? l : l + 1;
        ln_row_finish_q(p, r, lane, p.X() + (size_t)r * D, ya, mod_ptr(p, l, cnd, 5), p.vec() + V_LNG + (size_t)(l * 2 + 1) * D, p.vec() + V_LNB + (size_t)(l * 2 + 1) * D,
                        xo, !last, mod_ptr(p, ln, cnd, 1), mod_ptr(p, ln, cnd, 0));
    }
}

__device__ __forceinline__ void phase_peer(const Params& p, int l, char* smem, int tid) {
    const int lane = tid & 63, wid = tid >> 6;
    const int nblk = NT / 16, G = gridDim.x;
    int tb = blockIdx.x;
    if (tb >= nblk) return;
    {
        Params ps = p; int ls = lane; asm volatile("" : "+s"(ps.ws), "+v"(ls));
        select_wave<1>(ps, l, smem + (wid >> 2) * PL_SCR1, ls, tb, wid >> 2, wid & 3, smem + PL_LIST);
        __syncthreads();
    }
    int cur = 0;
    for (; tb < nblk; tb += G, cur ^= 1) {
        const bool has_next = tb + G < nblk;
        char* list = smem + PL_LIST + cur * PL_LIST_BYTES;
        if (has_next && wid >= 4) {
            Params ps = p; int ls = lane; asm volatile("" : "+s"(ps.ws), "+v"(ls));
            select_wave<2>(ps, l, smem + ((wid - 4) >> 1) * PL_SCR1, ls, tb + G, (wid - 4) >> 1, ((wid - 4) & 1) * 2, smem + PL_LIST + (cur ^ 1) * PL_LIST_BYTES);
#if PROBE_DUP == 32
            select_wave<2>(ps, l, smem + ((wid - 4) >> 1) * PL_SCR1, ls, tb + G, (wid - 4) >> 1, ((wid - 4) & 1) * 2, smem + PL_LIST + (cur ^ 1) * PL_LIST_BYTES);
#endif
        } else {
            const int ngw = has_next ? 4 : 8;
            const int* idl = (const int*)list; const float* gl = (const float*)(list + 8192);
#pragma unroll 1
            for (int tl = wid; tl < 16; tl += ngw) {
                Params pa = p; int la = lane; asm volatile("" : "+s"(pa.ws), "+v"(la));
                const int id0 = idl[tl * 128 + la], id1 = idl[tl * 128 + 64 + la];
                const float g0 = gl[tl * 128 + la], g1 = gl[tl * 128 + 64 + la];
                apply_token(pa, l, la, tb * 16 + tl, idl + tl * 128, id0, id1, g0, g1, smem + PW_SCR + wid * PW_STRIDE);
            }
        }
        __syncthreads();
    }
}

__device__ __forceinline__ void tail_convert(const Params& p, const Inputs& in, int l, int ntiles, int c0, int c1, int tid) {
    if (l + 1 >= DEPTH) return;
    const int G = gridDim.x, first = ntiles % G;
    int rank = -1, n = 0;
    if (first == 0) { rank = blockIdx.x; n = G; } else if ((int)blockIdx.x >= first) { rank = blockIdx.x - first; n = G - first; }
    if (rank < 0) return;
    const int nU = NEXP * D / 16384;
    const size_t lo = (size_t)(l + 1) * nU;
    for (int c = c0 + rank; c < c1; c += n) {
        if (c < nU) conv_chunk_fp4(in.pk_u, p.Ub(), lo + c, tid, U_SCALE);
        else conv_chunk_fp4v(in.pk_v, p.Vb(), lo + c - nU, tid, V_SCALE);
    }
}
__device__ __forceinline__ void phase_gemm1(const Params& p, const Inputs& in, int l, char* smem, int tid) {
    EpiProj e; e.pp = &p; e.l = l;
    gemm_phase(p.H(), p.WinT() + (size_t)l * INW * D, NT, INW, smem, e, tid);
    tail_convert(p, in, l, (NT / BM) * (INW / BM), 0, 1843, tid);
}
__device__ __forceinline__ void phase_gemm3(const Params& p, const Inputs& in, int l, char* smem, int tid) {
    EpiBf16 e; e.C = p.Y(); e.ldc = D;
    gemm_phase(p.MIX(), p.WoutT() + (size_t)l * D * D, NT, D, smem, e, tid);
    tail_convert(p, in, l, (NT / BM) * (D / BM), 1843, 2970, tid);
}
__device__ __forceinline__ void phase_gemm2(const Params& p, const Inputs& in, int l, char* smem, int tid) {
    EpiBf16 e; e.C = p.Qp(); e.ldc = D;
    gemm_phase(p.H(), p.WqT() + (size_t)l * D * D, NT, D, smem, e, tid);
    tail_convert(p, in, l, (NT / BM) * (D / BM), 2970, 4096, tid);
}

#define PHASE_ENTER Params q = p; int wv_ = wave_s; asm volatile("" : "+s"(q.ws), "+s"(q.out_g), "+s"(wv_)); int tid = (wv_ << 6) | lane_id(); asm volatile("" : "+v"(tid))
template <int PH>
__global__ void __launch_bounds__(512, 2) phase_kernel(Params p, Inputs in, int l) {
    extern __shared__ __attribute__((aligned(16))) char smem[];
    const int wave_s = __builtin_amdgcn_readfirstlane((int)(threadIdx.x >> 6));
    PHASE_ENTER;
    if (PH == 0) phase_prologue0(q, in, smem, tid);
    if (PH == 1) phase_prologue1(q, in, tid);
    if (PH == 2) phase_gemm1(q, in, l, smem, tid);
    if (PH == 3) phase_mixers(q, l, smem, tid);
    if (PH == 4) phase_gemm3(q, in, l, smem, tid);
    if (PH == 5) phase_ln1(q, l, tid);
    if (PH == 6) phase_gemm2(q, in, l, smem, tid);
    if (PH == 7) phase_peer(q, l, smem, tid);
}

#if MEGA
__global__ void __launch_bounds__(512, 2) mega_kernel(Params p, Inputs in) {
    extern __shared__ __attribute__((aligned(16))) char smem[];
    volatile LAS unsigned* st = (volatile LAS unsigned*)(smem + LDS_BAR_OFF);
    const int wave_s = __builtin_amdgcn_readfirstlane((int)(threadIdx.x >> 6));
    if (threadIdx.x == 0) { st[0] = 0u; st[1] = 0u; st[2] = 0u; st[3] = 0u; }
    __syncthreads();
    XcdBarrier bar = xcd_barrier_post(p.bar(), st);
    { PHASE_ENTER; phase_prologue0(q, in, smem, tid); } xcd_barrier(bar, wave_s);
#if PROBE_DUP == 6
    { PHASE_ENTER; phase_prologue0(q, in, smem, tid); } xcd_barrier(bar, wave_s);
#endif
    { PHASE_ENTER; phase_prologue1(q, in, tid); } xcd_barrier(bar, wave_s);
    for (int l = 0; l < DEPTH; ++l) {
        { PHASE_ENTER; phase_gemm1(q, in, l, smem, tid); } xcd_barrier(bar, wave_s);
#if PROBE_DUP == 3
        { PHASE_ENTER; phase_gemm1(q, in, l, smem, tid); } xcd_barrier(bar, wave_s);
#endif
        { PHASE_ENTER; phase_mixers(q, l, smem, tid); } xcd_barrier(bar, wave_s);
#if PROBE_DUP == 2
        { PHASE_ENTER; phase_mixers(q, l, smem, tid); } xcd_barrier(bar, wave_s);
#endif
        { PHASE_ENTER; phase_gemm3(q, in, l, smem, tid); } xcd_barrier(bar, wave_s);
#if PROBE_DUP == 4
        { PHASE_ENTER; phase_gemm3(q, in, l, smem, tid); } xcd_barrier(bar, wave_s);
#endif
        { PHASE_ENTER; phase_ln1(q, l, tid); } xcd_barrier(bar, wave_s);
        { PHASE_ENTER; phase_gemm2(q, in, l, smem, tid); } xcd_barrier(bar, wave_s);
        { PHASE_ENTER; phase_peer(q, l, smem, tid); } xcd_barrier(bar, wave_s);
    }
}
#endif

extern "C" void kernel_launch(void* const* d_in, const int* in_sizes, int n_in, void* d_out, int out_size, void* d_ws, size_t ws_size, hipStream_t stream) {
    (void)in_sizes; (void)n_in; (void)out_size;
    Params p{}; Inputs in{};
    const float* const* di = (const float* const*)d_in;
    in.x_prompt = di[0]; in.x_sample = di[1]; in.c_na_k = di[2]; in.c_na_v = di[3]; in.c_df_k1 = di[4]; in.c_df_k2 = di[5]; in.c_df_v = di[6];
    in.c = di[7]; in.c_ctx = di[8]; in.w_mod = di[9]; in.b_mod = di[10]; in.w_in = di[11]; in.na_rpb = di[12]; in.sg_ln_g = di[13]; in.sg_ln_b = di[14];
    in.sg_w = di[15]; in.sg_b = di[16]; in.df_lambda = di[17]; in.df_subln_g = di[18]; in.w_out = di[19]; in.pk_wq = di[20]; in.pk_keys = di[21];
    in.pk_u = di[22]; in.pk_v = di[23]; in.ln_g = di[24]; in.ln_b = di[25];
    p.ws = (GAS char*)d_ws; p.out_g = (GAS float*)d_out;
    if (ws_size < W_END) { fprintf(stderr, "workspace too small: %zu < %zu\n", ws_size, (size_t)W_END); return; }

    static int grid = 0;
    if (!grid) {
        int dev = 0, cus = 0;
        (void)hipGetDevice(&dev);
        (void)hipDeviceGetAttribute(&cus, hipDeviceAttributeMultiprocessorCount, dev);
        if (cus <= 0) cus = 256;
        grid = cus;
#if MEGA
        (void)hipFuncSetAttribute((const void*)mega_kernel, hipFuncAttributeMaxDynamicSharedMemorySize, LDS_BYTES);
        int per_cu = 0;
        (void)hipOccupancyMaxActiveBlocksPerMultiprocessor(&per_cu, (const void*)mega_kernel, 512, LDS_BYTES);
        if (per_cu < 1) fprintf(stderr, "mega_kernel: occupancy query says %d blocks per CU\n", per_cu);
#else
        (void)hipFuncSetAttribute((const void*)phase_kernel<0>, hipFuncAttributeMaxDynamicSharedMemorySize, LDS_BYTES);
        (void)hipFuncSetAttribute((const void*)phase_kernel<2>, hipFuncAttributeMaxDynamicSharedMemorySize, LDS_BYTES);
        (void)hipFuncSetAttribute((const void*)phase_kernel<3>, hipFuncAttributeMaxDynamicSharedMemorySize, LDS_BYTES);
        (void)hipFuncSetAttribute((const void*)phase_kernel<4>, hipFuncAttributeMaxDynamicSharedMemorySize, LDS_BYTES);
        (void)hipFuncSetAttribute((const void*)phase_kernel<6>, hipFuncAttributeMaxDynamicSharedMemorySize, LDS_BYTES);
        (void)hipFuncSetAttribute((const void*)phase_kernel<7>, hipFuncAttributeMaxDynamicSharedMemorySize, LDS_BYTES);
#endif
    }
#if MEGA
    (void)hipMemsetAsync((char*)d_ws + W_BAR, 0, XCD_BAR_WORDS * 4, stream);
    mega_kernel<<<grid, 512, LDS_BYTES, stream>>>(p, in);
#else
    phase_kernel<0><<<grid, 512, LDS_BYTES, stream>>>(p, in, 0);
    phase_kernel<1><<<grid, 512, 0, stream>>>(p, in, 0);
    for (int l = 0; l < DEPTH; ++l) {
        phase_kernel<2><<<grid, 512, LDS_BYTES, stream>>>(p, in, l);
        phase_kernel<3><<<grid, 512, LDS_BYTES, stream>>>(p, in, l);
        phase_kernel<4><<<grid, 512, LDS_BYTES, stream>>>(p, in, l);
        phase_kernel<5><<<grid, 512, 0, stream>>>(p, in, l);
        phase_kernel<6><<<grid, 512, LDS_BYTES, stream>>>(p, in, l);
        phase_kernel<7><<<grid, 512, LDS_BYTES, stream>>>(p, in, l);
    }
#endif
}
```

```cpp
#include <hip/hip_runtime.h>
#include <stdint.h>
#include <stdio.h>

#ifndef MEGA
#define MEGA 1
#endif
#ifndef PROBE_DUP
#define PROBE_DUP 0
#endif

typedef unsigned short bf16_t;
typedef short bf16x8 __attribute__((ext_vector_type(8)));
typedef float f32x4 __attribute__((ext_vector_type(4)));
typedef float f32x2 __attribute__((ext_vector_type(2)));
typedef unsigned u32x4 __attribute__((ext_vector_type(4)));
typedef unsigned u32x2 __attribute__((ext_vector_type(2)));
typedef __bf16 bf2_t __attribute__((ext_vector_type(2)));
typedef short s16x4 __attribute__((ext_vector_type(4)));
#define LAS __attribute__((address_space(3)))

constexpr int D = 2048;
constexpr int NP = 4096;
constexpr int NS = 8192;
constexpr int NT = NP + NS;
constexpr int INW = 5632;
constexpr int DEPTH = 4;
constexpr int NEXP = 16384;
constexpr float DN_ALPHA = 1.681792830507429f;
constexpr float LOG2E = 1.4426950408889634f;
constexpr int C_QA = 0, C_KA = 1024, C_VA = 2048, C_U = 3072, C_V = 3584, C_Q1 = 4096, C_Q2 = 4352, C_K1 = 4608, C_K2 = 4864, C_VC = 5120;
constexpr size_t O_YP = 0, O_YS = 8388608, O_NAK = 25165824, O_NAV = 41943040, O_K1 = 58720256, O_K2 = 62914560, O_DFV = 67108864;

constexpr int LDS_BYTES = 147456;
constexpr int LDS_BAR_OFF = LDS_BYTES - 64;

constexpr size_t al256c(size_t x) { return (x + 255) & ~(size_t)255; }
constexpr size_t W_BAR = 0;
constexpr size_t W_WINT = W_BAR + al256c(4096 * 4);
constexpr size_t W_WOUTT = W_WINT + al256c((size_t)DEPTH * INW * D * 2);
constexpr size_t W_WQT = W_WOUTT + al256c((size_t)DEPTH * D * D * 2);
constexpr size_t W_KEYSB = W_WQT + al256c((size_t)DEPTH * D * D * 2);
constexpr size_t W_UB = W_KEYSB + al256c((size_t)1048576 * 2);
constexpr int ROW4 = D / 2;
constexpr size_t W_VB = W_UB + al256c((size_t)DEPTH * NEXP * ROW4);
constexpr size_t W_CNAK = W_VB + al256c((size_t)DEPTH * NEXP * ROW4);
constexpr size_t W_CNAV = W_CNAK + al256c((size_t)2097152 * 2);
constexpr size_t W_CDK1 = W_CNAV + al256c((size_t)2097152 * 2);
constexpr size_t W_CDK2 = W_CDK1 + al256c((size_t)524288 * 2);
constexpr size_t W_CDV = W_CDK2 + al256c((size_t)524288 * 2);
constexpr size_t W_SGWB = W_CDV + al256c((size_t)1048576 * 2);
constexpr size_t W_MOD = W_SGWB + al256c((size_t)262144 * 2);
constexpr size_t W_ROPE = W_MOD + al256c((size_t)DEPTH * 3 * 6 * D * 4);
constexpr size_t W_LAM = W_ROPE + al256c(2048 * 4);
constexpr size_t W_VEC = W_LAM + 256;
constexpr size_t V_RPB = 0, V_SGLNG = V_RPB + 4 * 8 * 465, V_SGLNB = V_SGLNG + 4 * 512, V_SGB = V_SGLNB + 4 * 512, V_SUBG = V_SGB + 4 * 512,
                 V_LNG = V_SUBG + 4 * 128, V_LNB = V_LNG + 4 * 2 * D, V_END = V_LNB + 4 * 2 * D;
constexpr size_t W_X = W_VEC + al256c(V_END * 4);
constexpr size_t W_Y = W_X + al256c((size_t)NT * D * 4);
constexpr size_t W_H = W_Y + al256c((size_t)NT * D * 2);
constexpr size_t W_P = W_H + al256c((size_t)NT * D * 2);
constexpr size_t W_MIX = W_P + al256c((size_t)NT * INW * 2);
constexpr size_t W_QP = W_MIX + al256c((size_t)NT * D * 2);
constexpr size_t W_IDX = W_QP + al256c((size_t)NT * D * 2);
constexpr size_t W_G = W_IDX + al256c((size_t)NT * 128 * 4);
constexpr size_t W_END = W_G + al256c((size_t)NT * 128 * 4);

struct Inputs {
    const float *x_prompt, *x_sample, *c_na_k, *c_na_v, *c_df_k1, *c_df_k2, *c_df_v, *c, *c_ctx;
    const float *w_mod, *b_mod, *w_in, *na_rpb, *sg_ln_g, *sg_ln_b, *sg_w, *sg_b, *df_lambda, *df_subln_g, *w_out;
    const float *pk_wq, *pk_keys, *pk_u, *pk_v, *ln_g, *ln_b;
};
#define GAS __attribute__((address_space(1)))
struct Params {
    GAS char* ws; GAS float* out_g;
    __device__ __forceinline__ float* outp() const { return (float*)out_g; }
    __device__ __forceinline__ unsigned* bar() const { return (unsigned*)(ws + W_BAR); }
    __device__ __forceinline__ bf16_t* WinT() const { return (bf16_t*)(ws + W_WINT); }
    __device__ __forceinline__ bf16_t* WoutT() const { return (bf16_t*)(ws + W_WOUTT); }
    __device__ __forceinline__ bf16_t* WqT() const { return (bf16_t*)(ws + W_WQT); }
    __device__ __forceinline__ bf16_t* keysB() const { return (bf16_t*)(ws + W_KEYSB); }
    __device__ __forceinline__ unsigned char* Ub() const { return (unsigned char*)(ws + W_UB); }
    __device__ __forceinline__ unsigned char* Vb() const { return (unsigned char*)(ws + W_VB); }
    __device__ __forceinline__ bf16_t* cnak() const { return (bf16_t*)(ws + W_CNAK); }
    __device__ __forceinline__ bf16_t* cnav() const { return (bf16_t*)(ws + W_CNAV); }
    __device__ __forceinline__ bf16_t* cdk1() const { return (bf16_t*)(ws + W_CDK1); }
    __device__ __forceinline__ bf16_t* cdk2() const { return (bf16_t*)(ws + W_CDK2); }
    __device__ __forceinline__ bf16_t* cdv() const { return (bf16_t*)(ws + W_CDV); }
    __device__ __forceinline__ bf16_t* sgwB() const { return (bf16_t*)(ws + W_SGWB); }
    __device__ __forceinline__ float* mod() const { return (float*)(ws + W_MOD); }
    __device__ __forceinline__ float* rope() const { return (float*)(ws + W_ROPE); }
    __device__ __forceinline__ float* lam() const { return (float*)(ws + W_LAM); }
    __device__ __forceinline__ float* vec() const { return (float*)(ws + W_VEC); }
    __device__ __forceinline__ float* X() const { return (float*)(ws + W_X); }
    __device__ __forceinline__ bf16_t* Y() const { return (bf16_t*)(ws + W_Y); }
    __device__ __forceinline__ bf16_t* H() const { return (bf16_t*)(ws + W_H); }
    __device__ __forceinline__ bf16_t* P() const { return (bf16_t*)(ws + W_P); }
    __device__ __forceinline__ bf16_t* MIX() const { return (bf16_t*)(ws + W_MIX); }
    __device__ __forceinline__ bf16_t* Qp() const { return (bf16_t*)(ws + W_QP); }
    __device__ __forceinline__ int* IDX() const { return (int*)(ws + W_IDX); }
    __device__ __forceinline__ float* G() const { return (float*)(ws + W_G); }
};

__device__ __forceinline__ unsigned pack_bf2(float lo, float hi) {
    bf2_t v; v.x = (__bf16)lo; v.y = (__bf16)hi; return *(unsigned*)&v;
}
__device__ __forceinline__ float bf_lo(unsigned u) { return __uint_as_float(u << 16); }
__device__ __forceinline__ float bf_hi(unsigned u) { return __uint_as_float(u & 0xffff0000u); }
__device__ __forceinline__ float wave_sum(float v) {
#pragma unroll
    for (int s = 32; s >= 1; s >>= 1) v += __shfl_xor(v, s);
    return v;
}
__device__ __forceinline__ float lam_init_of(int l) {
    return l == 0 ? 0.2f : (l == 1 ? 0.35550907f : (l == 2 ? 0.47071302f : 0.55605820f));
}
__device__ __forceinline__ const float* xin_row(const Inputs& in, int r) {
    return r < NP ? in.x_prompt + (size_t)r * D : in.x_sample + (size_t)(r - NP) * D;
}
__device__ __forceinline__ int cond_of_row(int r) { return r < NP ? 0 : 1 + ((r - NP) >> 12); }
__device__ __forceinline__ const float* mod_ptr(const Params& p, int l, int cnd, int which) {
    return p.mod() + ((size_t)(l * 3 + cnd) * 6 + which) * D;
}

__device__ __forceinline__ int lane_id() { unsigned z = 0u; asm volatile("v_mov_b32 %0, 0" : "=v"(z)); return (int)__builtin_amdgcn_mbcnt_hi(~0u, __builtin_amdgcn_mbcnt_lo(~0u, z)); }

#define XB_TMO      128
#define XB_XCNT(j)  (256  + 64 * (j))
#define XB_XSUB(j)  (1280 + 64 * (j))
#define XB_XGEN(j)  (2304 + 64 * (j))
#define XB_TOP      3328
#define XB_TOPGEN   3392
#define XCD_BAR_WORDS 3456
#define XB_SPIN_CAP (1u << 22)

__device__ __forceinline__ unsigned xb_ld(unsigned* p)              { return __hip_atomic_load(p, __ATOMIC_RELAXED, __HIP_MEMORY_SCOPE_AGENT); }
__device__ __forceinline__ unsigned xb_add(unsigned* p, unsigned v) { return __hip_atomic_fetch_add(p, v, __ATOMIC_RELAXED, __HIP_MEMORY_SCOPE_AGENT); }
__device__ __forceinline__ unsigned xb_xcc_id() { return (unsigned)__builtin_amdgcn_s_getreg((3 << 11) | 20) & 0xFu; }
#define XB_SPIN(cond, bar) do { unsigned _sp = 0; while (cond) { __builtin_amdgcn_s_sleep(1); \
    if ((++_sp & 255u) == 0u) { if (xb_ld(&(bar)[XB_TMO])) break; if (_sp > XB_SPIN_CAP) { atomicAdd(&(bar)[XB_TMO], 1u); break; } } } } while (0)

struct XcdBarrier { unsigned* bar; unsigned x; volatile LAS unsigned* st; };

__device__ __forceinline__ XcdBarrier xcd_barrier_post(unsigned* bar, volatile LAS unsigned* st) {
    XcdBarrier b; b.bar = bar; b.x = xb_xcc_id(); b.st = st;
    if (threadIdx.x == 0) (void)xb_add(&bar[XB_XCNT(b.x)], 1u);
    return b;
}
__device__ __forceinline__ void xcd_barrier_complete(unsigned* bar, unsigned x, unsigned& nloc, unsigned& nx) {
    const unsigned G = gridDim.x * gridDim.y * gridDim.z;
    unsigned sum, cnt, mine, sp = 0u;
    for (;;) {
        sum = 0u; cnt = 0u; mine = 0u;
#pragma unroll
        for (unsigned j = 0; j < 16; ++j) { const unsigned c = xb_ld(&bar[XB_XCNT(j)]); sum += c; cnt += (c > 0u) ? 1u : 0u; mine = (j == x) ? c : mine; }
        if (sum == G) break;
        __builtin_amdgcn_s_sleep(1);
        if ((++sp & 255u) == 0u) { if (xb_ld(&bar[XB_TMO])) break; if (sp > XB_SPIN_CAP) { atomicAdd(&bar[XB_TMO], 1u); break; } }
    }
    nloc = mine > 0u ? mine : 1u; nx = cnt > 0u ? cnt : 1u;
}
__device__ __forceinline__ void xcd_barrier1(const XcdBarrier& b, int wave_s) {
    asm volatile("s_waitcnt vmcnt(0)" ::: "memory");
    __syncthreads();
    if (wave_s == 0 && lane_id() == 0) {
        unsigned* bar = b.bar; unsigned bx = b.x; asm volatile("" : "+s"(bar), "+s"(bx));
        __builtin_amdgcn_s_waitcnt(0);
        unsigned nloc = b.st[0], nx = b.st[1];
        if (nloc == 0u) { xcd_barrier_complete(bar, bx, nloc, nx); b.st[0] = nloc; b.st[1] = nx; }
        const unsigned old = xb_add(&bar[XB_XSUB(bx)], 1u);
        const unsigned gen = old / nloc;
        if (old + 1u == (gen + 1u) * nloc) {
            __builtin_amdgcn_fence(__ATOMIC_RELEASE, "agent");
            asm volatile("s_waitcnt vmcnt(0)" ::: "memory");
            const unsigned og = xb_add(&bar[XB_TOP], 1u);
            const unsigned tg = og / nx;
            if (og + 1u == (tg + 1u) * nx) xb_add(&bar[XB_TOPGEN], 1u);
            else XB_SPIN(xb_ld(&bar[XB_TOPGEN]) == tg, bar);
            __builtin_amdgcn_fence(__ATOMIC_ACQUIRE, "agent");
            xb_add(&bar[XB_XGEN(bx)], 1u);
            asm volatile("s_waitcnt vmcnt(0)" ::: "memory");
        } else {
            XB_SPIN(xb_ld(&bar[XB_XGEN(bx)]) == gen, bar);
            __builtin_amdgcn_fence(__ATOMIC_ACQUIRE, "agent");
            asm volatile("s_waitcnt vmcnt(0)" ::: "memory");
        }
    }
    __syncthreads();
}

__device__ __forceinline__ void xcd_barrier(const XcdBarrier& b, int wave_s) {
    xcd_barrier1(b, wave_s);
#if PROBE_DUP == 20
    xcd_barrier1(b, wave_s);
#endif
}

__device__ __forceinline__ void tconv_tile(const float* W, int N, bf16_t* Wt, int kt, int nt, bool permq, float* lds, int t) {
    __syncthreads();
#pragma unroll
    for (int i = 0; i < 2; ++i) {
        const int k = (t >> 4) + 32 * i, n4 = (t & 15) * 4;
        const f32x4 v = *(const f32x4*)(W + (size_t)(kt * 64 + k) * N + nt * 64 + n4);
        float* d = lds + k * 65 + n4;
        d[0] = v[0]; d[1] = v[1]; d[2] = v[2]; d[3] = v[3];
    }
    __syncthreads();
    const int q = t >> 3, k8 = (t & 7) * 8;
    const int dl = permq ? ((((q >> 4) & 1) << 5) | ((q >> 5) << 4) | (q & 15)) : q;
    u32x4 o;
    o[0] = pack_bf2(lds[(k8 + 0) * 65 + dl], lds[(k8 + 1) * 65 + dl]);
    o[1] = pack_bf2(lds[(k8 + 2) * 65 + dl], lds[(k8 + 3) * 65 + dl]);
    o[2] = pack_bf2(lds[(k8 + 4) * 65 + dl], lds[(k8 + 5) * 65 + dl]);
    o[3] = pack_bf2(lds[(k8 + 6) * 65 + dl], lds[(k8 + 7) * 65 + dl]);
    *(u32x4*)(Wt + (size_t)(nt * 64 + q) * D + kt * 64 + k8) = o;
}

__device__ __forceinline__ void conv_chunk(const float* src, bf16_t* dst, size_t chunk, int t) {
    const size_t e = chunk * 4096 + (size_t)t * 8;
    const f32x4 a = *(const f32x4*)(src + e), b = *(const f32x4*)(src + e + 4);
    u32x4 o; o[0] = pack_bf2(a[0], a[1]); o[1] = pack_bf2(a[2], a[3]); o[2] = pack_bf2(b[0], b[1]); o[3] = pack_bf2(b[2], b[3]);
    *(u32x4*)(dst + e) = o;
}

constexpr float U_SCALE = 92.0f, V_SCALE = 13.75f;
__device__ __forceinline__ void conv_chunk_fp4(const float* src, unsigned char* dst, size_t chunk, int t, float scale) {
    const size_t e = chunk * 16384 + (size_t)t * 32;
    u32x4 o;
#pragma unroll
    for (int w = 0; w < 4; ++w) {
        const f32x4 x0 = *(const f32x4*)(src + e + 8 * w), x1 = *(const f32x4*)(src + e + 8 * w + 4);
        unsigned r = 0;
        r = __builtin_amdgcn_cvt_scalef32_pk_fp4_f32(r, x0[0] * scale, x0[1] * scale, 1.0f, 0);
        r = __builtin_amdgcn_cvt_scalef32_pk_fp4_f32(r, x0[2] * scale, x0[3] * scale, 1.0f, 1);
        r = __builtin_amdgcn_cvt_scalef32_pk_fp4_f32(r, x1[0] * scale, x1[1] * scale, 1.0f, 2);
        r = __builtin_amdgcn_cvt_scalef32_pk_fp4_f32(r, x1[2] * scale, x1[3] * scale, 1.0f, 3);
        o[w] = r;
    }
    *(u32x4*)(dst + (e / 32) * 16) = o;
}

__device__ __forceinline__ void conv_chunk_fp4v(const float* src, unsigned char* dst, size_t chunk, int t, float scale) {
    const size_t e = chunk * 16384 + (size_t)t * 32;
    const int tq = t & 63, q = tq >> 4, fq = (tq >> 2) & 3, jh = (tq >> 1) & 1, nh = tq & 1;
    float x[32];
#pragma unroll
    for (int i = 0; i < 8; ++i) {
        const f32x4 v = *(const f32x4*)(src + e + 4 * i);
        x[4 * i] = v[0] * scale; x[4 * i + 1] = v[1] * scale; x[4 * i + 2] = v[2] * scale; x[4 * i + 3] = v[3] * scale;
    }
    unsigned char* o = dst + (e / D) * ROW4 + q * 256 + fq * 64 + jh * 8 + nh * 4;
#pragma unroll
    for (int reg = 0; reg < 4; ++reg) {
        unsigned r = 0;
        r = __builtin_amdgcn_cvt_scalef32_pk_fp4_f32(r, x[reg], x[4 + reg], 1.0f, 0);
        r = __builtin_amdgcn_cvt_scalef32_pk_fp4_f32(r, x[8 + reg], x[12 + reg], 1.0f, 1);
        r = __builtin_amdgcn_cvt_scalef32_pk_fp4_f32(r, x[16 + reg], x[20 + reg], 1.0f, 2);
        r = __builtin_amdgcn_cvt_scalef32_pk_fp4_f32(r, x[24 + reg], x[28 + reg], 1.0f, 3);
        *(unsigned*)(o + reg * 16) = r;
    }
}

__device__ __forceinline__ void phase_prologue0(const Params& p, const Inputs& in, char* smem, int tid) {
    float* lds = (float*)smem;
    const int t = tid, nb = gridDim.x, bid = blockIdx.x;
    {
        float* sc = lds;
        float* red = lds + 3 * D;
        for (int i = t; i < 3 * D; i += 512) {
            const int cnd = i / D, k = i % D;
            const float v = cnd == 0 ? in.c_ctx[k] : in.c[(cnd - 1) * D + k];
            sc[i] = v / (1.0f + __expf(-v));
        }
        __syncthreads();
        for (int u = bid; u < DEPTH * 192; u += nb) {
            const int l = u / 192, c0 = (u % 192) * 64;
            const int cg = t & 15, ks = t >> 4;
            float acc[3][4];
#pragma unroll
            for (int a = 0; a < 3; ++a)
#pragma unroll
                for (int j = 0; j < 4; ++j) acc[a][j] = 0.f;
            const float* wp = in.w_mod + ((size_t)l * D + ks * 64) * (6 * D) + c0 + cg * 4;
#pragma unroll 4
            for (int k = 0; k < 64; ++k) {
                const f32x4 w = *(const f32x4*)(wp + (size_t)k * (6 * D));
#pragma unroll
                for (int a = 0; a < 3; ++a) {
                    const float s = sc[a * D + ks * 64 + k];
#pragma unroll
                    for (int j = 0; j < 4; ++j) acc[a][j] += s * w[j];
                }
            }
#pragma unroll
            for (int a = 0; a < 3; ++a)
#pragma unroll
                for (int j = 0; j < 4; ++j) red[(ks * 16 + cg) * 12 + a * 4 + j] = acc[a][j];
            __syncthreads();
            if (t < 192) {
                const int cg2 = t / 12, aj = t % 12, a = aj >> 2, j = aj & 3;
                float s = 0.f;
                for (int k2 = 0; k2 < 32; ++k2) s += red[(k2 * 16 + cg2) * 12 + aj];
                const int col = c0 + cg2 * 4 + j;
                p.mod()[(size_t)(l * 3 + a) * (6 * D) + col] = s + in.b_mod[(size_t)l * 6 * D + col];
            }
            __syncthreads();
        }
    }
    if (bid == 0) {
        for (int i = t; i < 1024; i += 512) {
            const int pos = i >> 4, f = i & 15;
            const float inv = 1.0f / powf(10000.0f, (float)f / 16.0f);
            const float ang = (float)pos * inv;
            p.rope()[2 * i] = cosf(ang); p.rope()[2 * i + 1] = sinf(ang);
        }
        if (t < DEPTH) {
            const float* lp = in.df_lambda + t * 256;
            float a = 0.f, b = 0.f;
            for (int i = 0; i < 64; ++i) { a += lp[i] * lp[64 + i]; b += lp[128 + i] * lp[192 + i]; }
            p.lam()[t] = expf(a) - expf(b) + lam_init_of(t);
        }
    }
    {
        float* vv = p.vec();
        for (int i = bid * 512 + t; i < (int)V_END; i += nb * 512) {
            float v;
            if (i < (int)V_SGLNG) v = in.na_rpb[i - V_RPB];
            else if (i < (int)V_SGLNB) v = in.sg_ln_g[i - V_SGLNG];
            else if (i < (int)V_SGB) v = in.sg_ln_b[i - V_SGLNB];
            else if (i < (int)V_SUBG) v = in.sg_b[i - V_SGB];
            else if (i < (int)V_LNG) v = in.df_subln_g[i - V_SUBG];
            else if (i < (int)V_LNB) v = in.ln_g[i - V_LNG];
            else v = in.ln_b[i - V_LNB];
            vv[i] = v;
        }
    }
    {
        const int n_in = DEPTH * 32 * 88, n_sq = DEPTH * 32 * 32;
        for (int u = bid; u < n_in + 2 * n_sq; u += nb) {
            if (u < n_in) {
                const int l = u / (32 * 88), r = u % (32 * 88), nt = r / 32, kt = r % 32;
                const bool pq = (nt >= 64 && nt < 80);
                tconv_tile(in.w_in + (size_t)l * D * INW, INW, p.WinT() + (size_t)l * INW * D, kt, nt, pq, lds, t);
            } else if (u < n_in + n_sq) {
                const int v = u - n_in, l = v / 1024, r = v % 1024, nt = r / 32, kt = r % 32;
                tconv_tile(in.w_out + (size_t)l * D * D, D, p.WoutT() + (size_t)l * D * D, kt, nt, false, lds, t);
            } else {
                const int v = u - n_in - n_sq, l = v / 1024, r = v % 1024, nt = r / 32, kt = r % 32;
                tconv_tile(in.pk_wq + (size_t)l * D * D, D, p.WqT() + (size_t)l * D * D, kt, nt, false, lds, t);
            }
        }
    }
    {
        const size_t nU = (size_t)NEXP * D / 16384;
        const size_t n0 = 2 * nU, n1 = n0 + 512, n2 = n1 + 512, n3 = n2 + 128, n4 = n3 + 128, n5 = n4 + 256, n6 = n5 + 64, n7 = n6 + 256;
        for (size_t u = bid; u < n7; u += nb) {
            if (u < nU) conv_chunk_fp4(in.pk_u, p.Ub(), u, t, U_SCALE);
            else if (u < n0) conv_chunk_fp4v(in.pk_v, p.Vb(), u - nU, t, V_SCALE);
            else if (u < n1) conv_chunk(in.c_na_k, p.cnak(), u - n0, t);
            else if (u < n2) conv_chunk(in.c_na_v, p.cnav(), u - n1, t);
            else if (u < n3) conv_chunk(in.c_df_k1, p.cdk1(), u - n2, t);
            else if (u < n4) conv_chunk(in.c_df_k2, p.cdk2(), u - n3, t);
            else if (u < n5) conv_chunk(in.c_df_v, p.cdv(), u - n4, t);
            else if (u < n6) conv_chunk(in.sg_w, p.sgwB(), u - n5, t);
            else conv_chunk(in.pk_keys, p.keysB(), u - n6, t);
        }
    }
}

__device__ __forceinline__ void phase_prologue1(const Params& p, const Inputs& in, int tid) {
    const int lane = tid & 63, wv = blockIdx.x * 8 + (tid >> 6), nw = gridDim.x * 8;
    for (int r = wv; r < NT; r += nw) {
        const float* x = xin_row(in, r);
        const int cnd = cond_of_row(r);
        const float* sh = mod_ptr(p, 0, cnd, 0); const float* sc = mod_ptr(p, 0, cnd, 1);
#pragma unroll
        for (int i = 0; i < 4; ++i) {
            const int e = i * 512 + lane * 8;
            const f32x4 a = *(const f32x4*)(x + e), b = *(const f32x4*)(x + e + 4);
            *(f32x4*)(p.X() + (size_t)r * D + e) = a; *(f32x4*)(p.X() + (size_t)r * D + e + 4) = b;
            const f32x4 s0 = *(const f32x4*)(sc + e), s1 = *(const f32x4*)(sc + e + 4);
            const f32x4 h0 = *(const f32x4*)(sh + e), h1 = *(const f32x4*)(sh + e + 4);
            u32x4 o;
            o[0] = pack_bf2(a[0] * (1.f + s0[0]) + h0[0], a[1] * (1.f + s0[1]) + h0[1]);
            o[1] = pack_bf2(a[2] * (1.f + s0[2]) + h0[2], a[3] * (1.f + s0[3]) + h0[3]);
            o[2] = pack_bf2(b[0] * (1.f + s1[0]) + h1[0], b[1] * (1.f + s1[1]) + h1[1]);
            o[3] = pack_bf2(b[2] * (1.f + s1[2]) + h1[2], b[3] * (1.f + s1[3]) + h1[3]);
            *(u32x4*)(p.H() + (size_t)r * D + e) = o;
        }
    }
}

template <int CW>
__device__ __forceinline__ void ln_row_finish(const Params& p, int r, int lane, const float* xrow, const float (&y)[32], const float* gate,
                                              const float* lng, const float* lnb, float* xout, bool nxt, const float* scn, const float* shn) {
    constexpr int NCH = 32 / CW, NV = CW / 4;
    float t[32];
    float s = 0.f;
#pragma unroll
    for (int i = 0; i < NCH; ++i)
#pragma unroll
        for (int v = 0; v < NV; ++v) {
            const int e = i * 64 * CW + lane * CW + 4 * v;
            const f32x4 a = *(const f32x4*)(xrow + e), g0 = *(const f32x4*)(gate + e);
#pragma unroll
            for (int j = 0; j < 4; ++j) t[i * CW + 4 * v + j] = DN_ALPHA * a[j] + g0[j] * y[i * CW + 4 * v + j];
        }
#pragma unroll
    for (int i = 0; i < 32; ++i) s += t[i];
    const float mean = wave_sum(s) * (1.0f / D);
    float q = 0.f;
#pragma unroll
    for (int i = 0; i < 32; ++i) { const float d = t[i] - mean; q += d * d; }
    const float rstd = rsqrtf(wave_sum(q) * (1.0f / D) + 1e-5f);
#pragma unroll
    for (int i = 0; i < NCH; ++i)
#pragma unroll
        for (int v = 0; v < NV; v += 2) {
            const int e = i * 64 * CW + lane * CW + 4 * v;
            const f32x4 g0 = *(const f32x4*)(lng + e), g1 = *(const f32x4*)(lng + e + 4);
            const f32x4 b0 = *(const f32x4*)(lnb + e), b1 = *(const f32x4*)(lnb + e + 4);
            f32x4 o0, o1;
#pragma unroll
            for (int j = 0; j < 4; ++j) {
                o0[j] = (t[i * CW + 4 * v + j] - mean) * rstd * g0[j] + b0[j];
                o1[j] = (t[i * CW + 4 * v + 4 + j] - mean) * rstd * g1[j] + b1[j];
            }
            *(f32x4*)(xout + e) = o0; *(f32x4*)(xout + e + 4) = o1;
            if (nxt) {
                const f32x4 s0 = *(const f32x4*)(scn + e), s1 = *(const f32x4*)(scn + e + 4);
                const f32x4 h0 = *(const f32x4*)(shn + e), h1 = *(const f32x4*)(shn + e + 4);
                u32x4 o;
                o[0] = pack_bf2(o0[0] * (1.f + s0[0]) + h0[0], o0[1] * (1.f + s0[1]) + h0[1]);
                o[1] = pack_bf2(o0[2] * (1.f + s0[2]) + h0[2], o0[3] * (1.f + s0[3]) + h0[3]);
                o[2] = pack_bf2(o1[0] * (1.f + s1[0]) + h1[0], o1[1] * (1.f + s1[1]) + h1[1]);
                o[3] = pack_bf2(o1[2] * (1.f + s1[2]) + h1[2], o1[3] * (1.f + s1[3]) + h1[3]);
                *(u32x4*)(p.H() + (size_t)r * D + e) = o;
            }
        }
}

__device__ __forceinline__ void ln_row_finish_q(const Params& p, int r, int lane, const float* xrow, const f32x4 (&y)[8], const float* gate,
                                                const float* lng, const float* lnb, float* xout, bool nxt, const float* scn, const float* shn) {
    const int lo = (lane >> 4) * 128 + (lane & 15) * 4;
    f32x4 t[8];
    float s = 0.f;
#pragma unroll
    for (int c = 0; c < 8; ++c) {
        const int e = (c >> 1) * 512 + (c & 1) * 64 + lo;
        const f32x4 a = *(const f32x4*)(xrow + e), g0 = *(const f32x4*)(gate + e);
#pragma unroll
        for (int j = 0; j < 4; ++j) { t[c][j] = DN_ALPHA * a[j] + g0[j] * y[c][j]; s += t[c][j]; }
    }
    const float mean = wave_sum(s) * (1.0f / D);
    float q = 0.f;
#pragma unroll
    for (int c = 0; c < 8; ++c)
#pragma unroll
        for (int j = 0; j < 4; ++j) { const float d = t[c][j] - mean; q += d * d; }
    const float rstd = rsqrtf(wave_sum(q) * (1.0f / D) + 1e-5f);
#pragma unroll
    for (int c = 0; c < 8; ++c) {
        const int e = (c >> 1) * 512 + (c & 1) * 64 + lo;
        const f32x4 g0 = *(const f32x4*)(lng + e), b0 = *(const f32x4*)(lnb + e);
        f32x4 o0;
#pragma unroll
        for (int j = 0; j < 4; ++j) o0[j] = (t[c][j] - mean) * rstd * g0[j] + b0[j];
        *(f32x4*)(xout + e) = o0;
        if (nxt) {
            const f32x4 s0 = *(const f32x4*)(scn + e), h0 = *(const f32x4*)(shn + e);
            u32x2 o;
            o[0] = pack_bf2(o0[0] * (1.f + s0[0]) + h0[0], o0[1] * (1.f + s0[1]) + h0[1]);
            o[1] = pack_bf2(o0[2] * (1.f + s0[2]) + h0[2], o0[3] * (1.f + s0[3]) + h0[3]);
            *(u32x2*)(p.H() + (size_t)r * D + e) = o;
        }
    }
}

__device__ __forceinline__ void phase_ln1(const Params& p, int l, int tid) {
    const int lane = tid & 63, wv = blockIdx.x * 8 + (tid >> 6), nw = gridDim.x * 8;
    for (int r = wv; r < NT; r += nw) {
        const int cnd = cond_of_row(r);
        const float* xrow = p.X() + (size_t)r * D;
        float y[32];
#pragma unroll
        for (int i = 0; i < 4; ++i) {
            const int e = i * 512 + lane * 8;
            const u32x4 a = *(const u32x4*)(p.Y() + (size_t)r * D + e);
#pragma unroll
            for (int j = 0; j < 4; ++j) { y[i * 8 + 2 * j] = bf_lo(a[j]); y[i * 8 + 2 * j + 1] = bf_hi(a[j]); }
        }
        ln_row_finish<8>(p, r, lane, xrow, y, mod_ptr(p, l, cnd, 2), p.vec() + V_LNG + (size_t)(l * 2) * D, p.vec() + V_LNB + (size_t)(l * 2) * D,
                      p.X() + (size_t)r * D, true, mod_ptr(p, l, cnd, 4), mod_ptr(p, l, cnd, 3));
    }
}

constexpr int BM = 256, BK = 64, HALF = 128, HT = HALF * BK;
__device__ __forceinline__ int lds_byte(int r, int c) {
    int st = (r >> 4) * 2 + (c >> 5), rr = r & 15, cc = c & 31, ob = rr * 64 + cc * 2;
    return st * 1024 + (ob ^ (((ob >> 9) & 1) << 5));
}
__device__ __forceinline__ void stage_rc(int b, int& R, int& C) {
    int st = b / 1024, sb = b % 1024, swz = sb ^ (((sb >> 9) & 1) << 5);
    R = (st >> 1) * 16 + swz / 64; C = (st & 1) * 32 + (swz % 64) / 2;
}

template <class Epi>
__device__ __forceinline__ void gemm_tile(__amdgpu_buffer_rsrc_t A, __amdgpu_buffer_rsrc_t Bt, int brow, int bcol, bf16_t* shm, const Epi& epi, int tid) {
    constexpr int K = D;
#define SA(b, h) (shm + ((b) * 2 + (h)) * HT)
#define SB(b, h) (shm + (4 + (b) * 2 + (h)) * HT)
#define STAGE_X(T, P, RS, br, kt) do { const unsigned _so = (unsigned)(((br) * K + (kt) * BK) * 2); \
    __builtin_amdgcn_raw_ptr_buffer_load_lds(RS, (LAS void*)((char*)(P) + wbase), 16, so0, _so, 0, 0); \
    __builtin_amdgcn_raw_ptr_buffer_load_lds(RS, (LAS void*)((char*)(P) + wbase + 8192), 16, so1, _so, 0, 0); } while (0)
#define STAGE(P, RS, br, kt) STAGE_X(tid, P, RS, br, kt)
#define LDA(dst, b, h) for (int m = 0; m < 4; ++m) for (int k = 0; k < 2; ++k) \
    dst[m][k] = *reinterpret_cast<const bf16x8*>((char*)SA(b, h) + lds_byte(wr * 64 + m * 16 + fr, k * 32 + fq * 8))
#define LDB(dst, b, h) for (int n = 0; n < 2; ++n) for (int k = 0; k < 2; ++k) \
    dst[n][k] = *reinterpret_cast<const bf16x8*>((char*)SB(b, h) + lds_byte(wc * 32 + n * 16 + fr, k * 32 + fq * 8))
#define MMA(ai, bj, At, Bf) do { __builtin_amdgcn_s_setprio(1); \
    for (int m = 0; m < 4; ++m) for (int n = 0; n < 2; ++n) for (int k = 0; k < 2; ++k) \
      acc[ai][bj][m][n] = __builtin_amdgcn_mfma_f32_16x16x32_bf16(Bf[n][k], At[m][k], acc[ai][bj][m][n], 0, 0, 0); \
    __builtin_amdgcn_s_setprio(0); } while (0)
#define WAIT_V(n) asm volatile("s_waitcnt vmcnt(" #n ")" ::: "memory")
#define WAIT_L(n) asm volatile("s_waitcnt lgkmcnt(" #n ")" ::: "memory")
#define BAR __builtin_amdgcn_s_barrier()
#define SCHED __builtin_amdgcn_sched_barrier(0)
    int wid = tid >> 6, lane = tid & 63, wr = wid >> 2, wc = wid & 3, fr = lane & 15, fq = lane >> 4;
    f32x4 acc[2][2][4][2] = {};
    bf16x8 At[4][2], B0[2][2], B1[2][2];
    constexpr int nt = K / BK;
    const unsigned wbase = (unsigned)__builtin_amdgcn_readfirstlane(tid >> 6) * 1024u;
    unsigned so0, so1;
    { int r_, c_; stage_rc(tid * 16, r_, c_); so0 = (unsigned)(r_ * K + c_) * 2u; stage_rc(tid * 16 + 8192, r_, c_); so1 = (unsigned)(r_ * K + c_) * 2u; }
    STAGE(SB(0, 0), Bt, bcol, 0); STAGE(SA(0, 0), A, brow, 0);
    STAGE(SB(0, 1), Bt, bcol + HALF, 0); STAGE(SA(0, 1), A, brow + HALF, 0);
    if (wr == 1) BAR;
    WAIT_V(4); BAR;
    STAGE(SB(1, 0), Bt, bcol, 1); STAGE(SA(1, 0), A, brow, 1); STAGE(SB(1, 1), Bt, bcol + HALF, 1);
    WAIT_V(6); BAR;
    for (int t = 0; t < nt - 2; t += 2) {
        LDB(B0, 0, 0); SCHED; LDA(At, 0, 0); STAGE(SA(1, 1), A, brow + HALF, t + 1);
        WAIT_L(8); BAR; WAIT_L(0); MMA(0, 0, At, B0); BAR; SCHED;
        LDB(B1, 0, 1); STAGE(SB(0, 0), Bt, bcol, t + 2);
        BAR; WAIT_L(0); MMA(0, 1, At, B1); BAR;
        LDA(At, 0, 1); STAGE(SA(0, 0), A, brow, t + 2);
        BAR; WAIT_L(0); MMA(1, 0, At, B0); BAR; SCHED;
        STAGE(SB(0, 1), Bt, bcol + HALF, t + 2);
        WAIT_V(6); BAR; MMA(1, 1, At, B1); BAR;
        LDB(B0, 1, 0); SCHED; LDA(At, 1, 0); STAGE(SA(0, 1), A, brow + HALF, t + 2);
        WAIT_L(8); BAR; WAIT_L(0); MMA(0, 0, At, B0); BAR; SCHED;
        LDB(B1, 1, 1); STAGE(SB(1, 0), Bt, bcol, t + 3);
        BAR; WAIT_L(0); MMA(0, 1, At, B1); BAR;
        LDA(At, 1, 1); STAGE(SA(1, 0), A, brow, t + 3);
        BAR; WAIT_L(0); MMA(1, 0, At, B0); BAR; SCHED;
        STAGE(SB(1, 1), Bt, bcol + HALF, t + 3);
        WAIT_V(6); BAR; MMA(1, 1, At, B1); BAR;
    }
    int tz = tid; asm volatile("" : "+v"(tz)); wid = tz >> 6; lane = tz & 63; wr = wid >> 2; wc = wid & 3; fr = lane & 15; fq = lane >> 4;
    { LDB(B0, 0, 0); WAIT_V(0); LDA(At, 0, 0); STAGE_X(tz, SA(1, 1), A, brow + HALF, nt - 1);
      BAR; WAIT_L(0); MMA(0, 0, At, B0); BAR;
      LDB(B1, 0, 1); BAR; WAIT_L(0); MMA(0, 1, At, B1); BAR;
      LDA(At, 0, 1); WAIT_V(4); BAR; WAIT_L(0); MMA(1, 0, At, B0); MMA(1, 1, At, B1); BAR; }
    { LDB(B0, 1, 0); LDA(At, 1, 0); WAIT_V(2); BAR; WAIT_L(0); MMA(0, 0, At, B0); BAR;
      LDB(B1, 1, 1); WAIT_V(0); BAR; WAIT_L(0); MMA(0, 1, At, B1); BAR;
      LDA(At, 1, 1); BAR; WAIT_L(0); MMA(1, 0, At, B0); MMA(1, 1, At, B1); BAR; }
    if (wr == 0) BAR;
    epi(acc, brow, bcol, wr, wc, fr, fq, (char*)shm, tz);
#undef SA
#undef SB
#undef STAGE_X
#undef STAGE
#undef LDA
#undef LDB
#undef MMA
}

__device__ __forceinline__ bool tile_of(int i, int nM, int nN, int& pm, int& pn) {
    const int nwg = nM * nN;
    const long L = (long)i * gridDim.x + blockIdx.x;
    if (L >= nwg) return false;
    int wgid = (int)L;
    { const int q = nwg / 8, r = nwg % 8, xcd = wgid % 8, off = wgid / 8; wgid = (xcd < r ? xcd * (q + 1) : r * (q + 1) + (xcd - r) * q) + off; }
    constexpr int WGM = 4;
    const int nig = WGM * nN, gid = wgid / nig, fm = gid * WGM, gsz = (nM - fm) < WGM ? (nM - fm) : WGM;
    pm = fm + ((wgid % nig) % gsz); pn = (wgid % nig) / gsz;
    return true;
}

constexpr int EPI_RS = 528;
__device__ __forceinline__ void epi_flush_bf16(const char* img, bf16_t* C, int ldc, int tid) {
    __syncthreads();
    const int r0 = (tid >> 6) * 32 + ((tid & 63) >> 5), cb = (tid & 31) * 16;
#pragma unroll 1
    for (int h = 0; h < 2; ++h) {
        u32x4 v[8];
#pragma unroll
        for (int i = 0; i < 8; ++i) v[i] = *(const u32x4*)(img + (r0 + 16 * h + 2 * i) * EPI_RS + cb);
#pragma unroll
        for (int i = 0; i < 8; ++i) __builtin_nontemporal_store(v[i], (u32x4*)((char*)(C + (size_t)(r0 + 16 * h + 2 * i) * ldc) + cb));
    }
    __syncthreads();
}

struct EpiProj {
    const Params* pp; int l;
    __device__ __forceinline__ void operator()(const f32x4 (&acc)[2][2][4][2], int brow, int bcol, int wr, int wc, int fr, int fq, char* img, int tid) const {
        const Params& p = *pp;
        const int pn = bcol >> 8;
        const bool prompt = brow < NP;
        if (pn >= 16 && pn < 20) {
#pragma unroll
            for (int ai = 0; ai < 2; ++ai)
#pragma unroll
                for (int m = 0; m < 4; ++m) {
                    const int row = brow + ai * HALF + wr * 64 + m * 16 + fr;
#pragma unroll
                    for (int bj = 0; bj < 2; ++bj) {
                        const int hh = bj * 2 + (wc >> 1);
                        const int i0 = (wc & 1) * 16 + 4 * fq;
                        f32x4 x1 = acc[ai][bj][m][0], x2 = acc[ai][bj][m][1];
                        if (!prompt) {
                            const int tk = (row - NP) & 4095;
                            const int pos = (wc & 1) ? (tk & 63) : (tk >> 6);
                            const float* cs = p.rope() + (size_t)(pos * 16 + 4 * fq) * 2;
                            const f32x4 c01 = *(const f32x4*)cs, c23 = *(const f32x4*)(cs + 4);
                            const float cc[4] = {c01[0], c01[2], c23[0], c23[2]}, ss[4] = {c01[1], c01[3], c23[1], c23[3]};
                            f32x4 y1, y2;
#pragma unroll
                            for (int j = 0; j < 4; ++j) { y1[j] = x1[j] * cc[j] - x2[j] * ss[j]; y2[j] = x1[j] * ss[j] + x2[j] * cc[j]; }
                            x1 = y1; x2 = y2;
                        }
                        char* pr = img + (row - brow) * EPI_RS + (hh * 64 + i0) * 2;
                        u32x2 o1, o2;
                        o1[0] = pack_bf2(x1[0], x1[1]); o1[1] = pack_bf2(x1[2], x1[3]);
                        o2[0] = pack_bf2(x2[0], x2[1]); o2[1] = pack_bf2(x2[2], x2[3]);
                        *(u32x2*)pr = o1; *(u32x2*)(pr + 64) = o2;
                    }
                }
        } else {
#pragma unroll
            for (int ai = 0; ai < 2; ++ai)
#pragma unroll
                for (int m = 0; m < 4; ++m) {
                    const int row = brow + ai * HALF + wr * 64 + m * 16 + fr;
#pragma unroll
                    for (int bj = 0; bj < 2; ++bj)
#pragma unroll
                        for (int n = 0; n < 2; ++n) {
                            const int col = bcol + bj * HALF + wc * 32 + n * 16 + 4 * fq;
                            const f32x4 v = acc[ai][bj][m][n];
                            u32x2 o; o[0] = pack_bf2(v[0], v[1]); o[1] = pack_bf2(v[2], v[3]);
                            *(u32x2*)(img + (row - brow) * EPI_RS + (col - bcol) * 2) = o;
                        }
                }
        }
        epi_flush_bf16(img, p.P() + (size_t)brow * INW + bcol, INW, tid);
        float* ob = nullptr; int hd = 128, nh = 8, hbase = 0;
        if (prompt) {
            if (pn >= 4 && pn < 8) { ob = p.outp() + O_NAK; hbase = (bcol - C_KA) >> 7; }
            else if (pn >= 8 && pn < 12) { ob = p.outp() + O_NAV; hbase = (bcol - C_VA) >> 7; }
            else if (pn >= 20) { ob = p.outp() + O_DFV; hbase = (bcol - C_VC) >> 7; nh = 4; }
            else if (pn == 18) { ob = p.outp() + O_K1; hd = 64; nh = 4; }
            else if (pn == 19) { ob = p.outp() + O_K2; hd = 64; nh = 4; }
        }
        if (ob) {
            const int b = brow >> 8;
#pragma unroll
            for (int hb = 0; hb < 2; ++hb) {
#pragma unroll
                for (int ai = 0; ai < 2; ++ai)
#pragma unroll
                    for (int m = 0; m < 4; ++m) {
                        char* rp = img + (ai * HALF + wr * 64 + m * 16 + fr) * EPI_RS;
                        if (hd == 64) {
                            const int cf = (wc >> 1) * 64 + (wc & 1) * 16 + 4 * fq;
                            *(f32x4*)(rp + cf * 4) = acc[ai][hb][m][0]; *(f32x4*)(rp + (cf + 32) * 4) = acc[ai][hb][m][1];
                        } else {
#pragma unroll
                            for (int n = 0; n < 2; ++n) *(f32x4*)(rp + (wc * 32 + n * 16 + 4 * fq) * 4) = acc[ai][hb][m][n];
                        }
                    }
                __syncthreads();
                const int r0 = (tid >> 6) * 32 + ((tid & 63) >> 5), c4 = tid & 31;
                float* dst = hd == 64 ? ob + (((size_t)b * DEPTH + l) * 4 + 2 * hb + (c4 >> 4)) * 256 * 64 + (c4 & 15) * 4
                                      : ob + (((size_t)b * DEPTH + l) * nh + hbase + hb) * 256 * 128 + c4 * 4;
#pragma unroll 1
                for (int h2 = 0; h2 < 2; ++h2) {
                    f32x4 v[8];
#pragma unroll
                    for (int i = 0; i < 8; ++i) v[i] = *(const f32x4*)(img + (r0 + 16 * h2 + 2 * i) * EPI_RS + c4 * 16);
#pragma unroll
                    for (int i = 0; i < 8; ++i) __builtin_nontemporal_store(v[i], (f32x4*)(dst + (size_t)(r0 + 16 * h2 + 2 * i) * hd));
                }
                __syncthreads();
            }
        }
    }
};
struct EpiF32 {
    float* C; int ldc;
    __device__ __forceinline__ void operator()(const f32x4 (&acc)[2][2][4][2], int brow, int bcol, int wr, int wc, int fr, int fq, char*, int) const {
#pragma unroll
        for (int ai = 0; ai < 2; ++ai)
#pragma unroll
            for (int m = 0; m < 4; ++m) {
                float* rp = C + (size_t)(brow + ai * HALF + wr * 64 + m * 16 + fr) * ldc + bcol + wc * 32 + 4 * fq;
#pragma unroll
                for (int bj = 0; bj < 2; ++bj)
#pragma unroll
                    for (int n = 0; n < 2; ++n) *(f32x4*)(rp + bj * HALF + n * 16) = acc[ai][bj][m][n];
            }
    }
};
struct EpiBf16 {
    bf16_t* C; int ldc;
    __device__ __forceinline__ void operator()(const f32x4 (&acc)[2][2][4][2], int brow, int bcol, int wr, int wc, int fr, int fq, char* img, int tid) const {
#pragma unroll
        for (int ai = 0; ai < 2; ++ai)
#pragma unroll
            for (int m = 0; m < 4; ++m) {
                char* rp = img + (ai * HALF + wr * 64 + m * 16 + fr) * EPI_RS + (wc * 32 + 4 * fq) * 2;
#pragma unroll
                for (int bj = 0; bj < 2; ++bj)
#pragma unroll
                    for (int n = 0; n < 2; ++n) {
                        const f32x4 v = acc[ai][bj][m][n];
                        u32x2 o; o[0] = pack_bf2(v[0], v[1]); o[1] = pack_bf2(v[2], v[3]);
                        *(u32x2*)(rp + (bj * HALF + n * 16) * 2) = o;
                    }
            }
        epi_flush_bf16(img, C + (size_t)brow * ldc + bcol, ldc, tid);
    }
};

template <class Epi>
__device__ __forceinline__ void gemm_phase(const bf16_t* A, const bf16_t* Bt, int M, int N, char* smem, const Epi& epi, int tid) {
    const int nM = M / BM, nN = N / BM;
    const __amdgpu_buffer_rsrc_t rA = __builtin_amdgcn_make_buffer_rsrc((void*)A, 0, M * D * 2, 0x00020000);
    const __amdgpu_buffer_rsrc_t rB = __builtin_amdgcn_make_buffer_rsrc((void*)Bt, 0, N * D * 2, 0x00020000);
    for (int i = 0;; ++i) {
        int pm, pn;
        if (!tile_of(i, nM, nN, pm, pn)) break;
        gemm_tile(rA, rB, pm * BM, pn * BM, (bf16_t*)smem, epi, tid);
        __syncthreads();
    }
}

struct AttnArgs {
    const bf16_t* q[2]; int ldq;
    const bf16_t* k[2][2]; const bf16_t* v[2];
    int ldk[2], ldv[2], nt[2];
    bf16_t* o;
    float scale_l2;
    const float* rpb; int r, r0;
    float lam, oml; const float* subg;
};
constexpr int VSTR = 288;
constexpr int ATT_GROUP_LDS = 40960;

template <int NMAP, int DQK, bool NA, bool SHARE>
__device__ __forceinline__ void attn_group(const AttnArgs& a, char* lds, int gtid, int ltid) {
    constexpr int NTH = SHARE ? 512 : 256;
    constexpr int TK = 64;
    constexpr int NSUB = TK / 64;
    constexpr int KSTR = DQK * 2;
    constexpr int KCH = DQK / 8;
    constexpr int KPT = NMAP * TK * KCH / NTH;
    constexpr int VPT = TK * 16 / NTH;
    constexpr int NS_ = DQK / 32;
    constexpr bool DB = SHARE;
    constexpr int BUFSZ = NMAP * TK * KSTR + TK * VSTR;
    char* Kt = lds;
    char* Vt = lds + NMAP * TK * KSTR;
    float* rpbl = (float*)(lds + BUFSZ);
    const int lane = gtid & 63, wg = gtid >> 6, fr = lane & 15, fq = lane >> 4;

    if (NA) { for (int i = gtid; i < 465; i += 256) rpbl[i] = a.rpb[i] * LOG2E; }

    bf16x8 Qf[NMAP][NS_];
#pragma unroll
    for (int mp = 0; mp < NMAP; ++mp)
#pragma unroll
        for (int s = 0; s < NS_; ++s)
            Qf[mp][s] = *(const bf16x8*)(a.q[mp] + (size_t)(wg * 16 + fr) * a.ldq + 32 * s + 8 * fq);

    f32x4 O[NMAP][8];
    float mrun[NMAP], lrun[NMAP];
#pragma unroll
    for (int mp = 0; mp < NMAP; ++mp) {
        mrun[mp] = -1e30f; lrun[mp] = 0.f;
#pragma unroll
        for (int c = 0; c < 8; ++c) O[mp][c] = (f32x4){0.f, 0.f, 0.f, 0.f};
    }

    const int T = (a.nt[0] + a.nt[1]) / NSUB;
    const int T0 = a.nt[0] / NSUB;
    int na_lo = 0, na_hi = 63;
    if (NA) { int lo = 16 * wg - 8; lo = lo < 0 ? 0 : (lo > 48 ? 48 : lo); int hi = 16 * wg + 7; hi = (hi < 0 ? 0 : (hi > 48 ? 48 : hi)) + 15; na_lo = lo; na_hi = hi; }
    u32x4 kreg[KPT], vreg[VPT];
    auto issue = [&](int t) {
        const bool s1 = t >= T0;
        const int tt = s1 ? t - T0 : t;
        const bf16_t* k0p = s1 ? a.k[1][0] : a.k[0][0];
        const bf16_t* k1p = s1 ? a.k[1][1] : a.k[0][1];
        const bf16_t* vp = s1 ? a.v[1] : a.v[0];
        const int ldk = s1 ? a.ldk[1] : a.ldk[0], ldv = s1 ? a.ldv[1] : a.ldv[0];
#pragma unroll
        for (int i = 0; i < KPT; ++i) {
            const int idx = ltid + NTH * i, mp = idx / (TK * KCH), rem = idx % (TK * KCH), row = rem / KCH, ch = rem % KCH;
            kreg[i] = *(const u32x4*)((NMAP == 2 && mp ? k1p : k0p) + (size_t)(tt * TK + row) * ldk + ch * 8);
        }
#pragma unroll
        for (int i = 0; i < VPT; ++i) {
            const int idx = ltid + NTH * i, row = idx >> 4, ch = idx & 15;
            vreg[i] = *(const u32x4*)(vp + (size_t)(tt * TK + row) * ldv + ch * 8);
        }
    };
    auto stash = [&](int buf) {
        char* Kb = lds + buf * BUFSZ; char* Vb = Kb + NMAP * TK * KSTR;
#pragma unroll
        for (int i = 0; i < KPT; ++i) {
            const int idx = ltid + NTH * i, mp = idx / (TK * KCH), rem = idx % (TK * KCH), row = rem / KCH, ch = rem % KCH;
            *(u32x4*)(Kb + (mp * TK + row) * KSTR + ((ch ^ (DQK == 64 ? ((row >> 1) & 7) : (row & 15))) * 16)) = kreg[i];
        }
#pragma unroll
        for (int i = 0; i < VPT; ++i) {
            const int idx = ltid + NTH * i, row = idx >> 4, ch = idx & 15;
            *(u32x4*)(Vb + row * VSTR + ch * 16) = vreg[i];
        }
    };
    issue(0);
    if (DB) { stash(0); __syncthreads(); if (1 < T) issue(1); }
    for (int t = 0; t < T; ++t) {
        if (!DB) {
            __syncthreads();
            stash(0);
            __syncthreads();
            if (t + 1 < T) issue(t + 1);
        } else {
            Kt = lds + (t & 1) * BUFSZ; Vt = Kt + NMAP * TK * KSTR;
        }

        const bool masked = NA && t < T0;
#pragma unroll
        for (int sub = 0; sub < NSUB; ++sub) {
            const char* Ks = Kt + sub * 64 * KSTR;
            const char* Vs = Vt + sub * 64 * VSTR;
            f32x4 S[NMAP][4];
#pragma unroll
            for (int mp = 0; mp < NMAP; ++mp) {
                bf16x8 kfr[4][NS_];
#pragma unroll
                for (int kt = 0; kt < 4; ++kt)
#pragma unroll
                    for (int s = 0; s < NS_; ++s)
                        kfr[kt][s] = *(const bf16x8*)(Ks + (mp * TK + 16 * kt + fr) * KSTR + (((4 * s + fq) ^ (DQK == 64 ? (fr >> 1) : fr)) * 16));
                __builtin_amdgcn_sched_barrier(0);
#pragma unroll
                for (int kt = 0; kt < 4; ++kt) {
                    f32x4 sacc = (f32x4){0.f, 0.f, 0.f, 0.f};
                    const bool live = !masked || (16 * kt + 15 >= na_lo && 16 * kt <= na_hi);
                    if (live) {
#pragma unroll
                        for (int s = 0; s < NS_; ++s) sacc = __builtin_amdgcn_mfma_f32_16x16x32_bf16(kfr[kt][s], Qf[mp][s], sacc, 0, 0, 0);
                    }
                    S[mp][kt] = sacc;
                }
            }
            const int qq = (lane & 15) >> 2, pp = lane & 3;
            bf16x8 vfp[2][2][2];
#define VREAD(buf, cb) _Pragma("unroll") for (int c2 = 0; c2 < 2; ++c2) _Pragma("unroll") for (int ks = 0; ks < 2; ++ks) { \
                const char* base = Vs + (32 * ks + 4 * fq + qq) * VSTR + (16 * ((cb) * 2 + c2) + 4 * pp) * 2; \
                const s16x4 v0 = __builtin_amdgcn_ds_read_tr16_b64_v4i16((LAS s16x4*)base); \
                const s16x4 v1 = __builtin_amdgcn_ds_read_tr16_b64_v4i16((LAS s16x4*)(base + 16 * VSTR)); \
                vfp[buf][c2][ks] = __builtin_shufflevector(v0, v1, 0, 1, 2, 3, 4, 5, 6, 7); }
#if PROBE_DUP == 40
#define VMMA(buf, cb) _Pragma("unroll") for (int c2 = 0; c2 < 2; ++c2) _Pragma("unroll") for (int ks = 0; ks < 2; ++ks) _Pragma("unroll") for (int mp = 0; mp < NMAP; ++mp) { \
                O[mp][(cb) * 2 + c2] = __builtin_amdgcn_mfma_f32_16x16x32_bf16(vfp[buf][c2][ks], Pf[mp][ks], O[mp][(cb) * 2 + c2], 0, 0, 0); \
                O[mp][(cb) * 2 + c2] = __builtin_amdgcn_mfma_f32_16x16x32_bf16(vfp[buf][c2][ks], Pf[mp][ks], O[mp][(cb) * 2 + c2], 0, 0, 0); }
#else
#define VMMA(buf, cb) _Pragma("unroll") for (int c2 = 0; c2 < 2; ++c2) _Pragma("unroll") for (int ks = 0; ks < 2; ++ks) _Pragma("unroll") for (int mp = 0; mp < NMAP; ++mp) \
                O[mp][(cb) * 2 + c2] = __builtin_amdgcn_mfma_f32_16x16x32_bf16(vfp[buf][c2][ks], Pf[mp][ks], O[mp][(cb) * 2 + c2], 0, 0, 0);
#endif
            VREAD(0, 0)
            __builtin_amdgcn_sched_barrier(0);
            bf16x8 Pf[NMAP][2];
#pragma unroll
            for (int mp = 0; mp < NMAP; ++mp) {
                float tmax = -1e30f;
                if (NA && masked) {
#pragma unroll
                    for (int kt = 0; kt < 4; ++kt)
#pragma unroll
                        for (int j = 0; j < 4; ++j) {
                            const int cc = 16 * kt + 4 * fq + j, c = wg * 16 + fr;
                            int cs = c - 8; cs = cs < 0 ? 0 : (cs > 48 ? 48 : cs);
                            const bool ok = (cc >= cs) && (cc < cs + 16);
                            const int dr = a.r0 + t - a.r + 7, dc = cc - c + 15;
                            const float sv = ok ? S[mp][kt][j] * a.scale_l2 + rpbl[dr * 31 + (ok ? dc : 0)] : -__builtin_inff();
                            S[mp][kt][j] = sv;
                            tmax = fmaxf(tmax, sv);
                        }
                } else {
                    float rmax = -1e30f;
#pragma unroll
                    for (int kt = 0; kt < 4; ++kt) rmax = fmaxf(rmax, fmaxf(fmaxf(S[mp][kt][0], S[mp][kt][1]), fmaxf(S[mp][kt][2], S[mp][kt][3])));
                    tmax = rmax * a.scale_l2;
                }
                tmax = fmaxf(tmax, __shfl_xor(tmax, 16));
                tmax = fmaxf(tmax, __shfl_xor(tmax, 32));
                const bool rebase = !__all(tmax - mrun[mp] <= 8.0f);
                const float mnew = rebase ? fmaxf(mrun[mp], tmax) : mrun[mp];
                const float alpha = rebase ? __builtin_amdgcn_exp2f(mrun[mp] - mnew) : 1.0f;
                mrun[mp] = mnew;
                float ls = 0.f;
                if (NA && masked) {
#pragma unroll
                    for (int kt = 0; kt < 4; ++kt)
#pragma unroll
                        for (int j = 0; j < 4; ++j) { const float pe = __builtin_amdgcn_exp2f(S[mp][kt][j] - mnew); S[mp][kt][j] = pe; ls += pe; }
                } else {
#pragma unroll
                    for (int kt = 0; kt < 4; ++kt)
#pragma unroll
#if PROBE_DUP == 41
                        for (int j = 0; j < 4; ++j) { float xin = __builtin_fmaf(S[mp][kt][j], a.scale_l2, -mnew); const float pe = __builtin_amdgcn_exp2f(xin); asm volatile("" : "+v"(xin));
                            const float pe2 = __builtin_amdgcn_exp2f(xin); const float pe3 = __builtin_amdgcn_exp2f(xin * 0.5f); S[mp][kt][j] = pe; ls += pe + 0.0f * (pe2 + pe3); }
#else
                        for (int j = 0; j < 4; ++j) { const float pe = __builtin_amdgcn_exp2f(__builtin_fmaf(S[mp][kt][j], a.scale_l2, -mnew)); S[mp][kt][j] = pe; ls += pe; }
#endif
                }
                lrun[mp] = lrun[mp] * alpha + ls;
                if (rebase) {
#pragma unroll
                    for (int c = 0; c < 8; ++c) O[mp][c] *= alpha;
                }
#pragma unroll
                for (int ks = 0; ks < 2; ++ks) {
                    u32x4 w;
#if PROBE_DUP == 40
#define PH_ 0.5f *
#else
#define PH_
#endif
                    w[0] = pack_bf2(PH_ S[mp][2 * ks][0], PH_ S[mp][2 * ks][1]); w[1] = pack_bf2(PH_ S[mp][2 * ks][2], PH_ S[mp][2 * ks][3]);
                    w[2] = pack_bf2(PH_ S[mp][2 * ks + 1][0], PH_ S[mp][2 * ks + 1][1]); w[3] = pack_bf2(PH_ S[mp][2 * ks + 1][2], PH_ S[mp][2 * ks + 1][3]);
#undef PH_
                    Pf[mp][ks] = *(bf16x8*)&w;
                }
            }
            __builtin_amdgcn_sched_barrier(0);
            VREAD(1, 1)
            __builtin_amdgcn_sched_barrier(0);
            VMMA(0, 0)
            __builtin_amdgcn_sched_barrier(0);
            VREAD(0, 2)
            __builtin_amdgcn_sched_barrier(0);
            VMMA(1, 1)
            __builtin_amdgcn_sched_barrier(0);
            VREAD(1, 3)
            __builtin_amdgcn_sched_barrier(0);
            VMMA(0, 2)
            VMMA(1, 3)
#undef VREAD
#undef VMMA
        }
        if (DB) {
            if (t + 1 < T) stash((t + 1) & 1);
            __syncthreads();
            if (t + 2 < T) issue(t + 2);
        }
    }
    float inv[NMAP];
#pragma unroll
    for (int mp = 0; mp < NMAP; ++mp) {
        float l = lrun[mp]; l += __shfl_xor(l, 16); l += __shfl_xor(l, 32); inv[mp] = 1.0f / l;
    }
    bf16_t* orow = a.o + (size_t)(wg * 16 + fr) * D;
    if (NMAP == 1) {
#pragma unroll
        for (int c = 0; c < 8; ++c) {
            const f32x4 v = O[0][c] * inv[0];
            u32x2 o; o[0] = pack_bf2(v[0], v[1]); o[1] = pack_bf2(v[2], v[3]);
            *(u32x2*)(orow + 16 * c + 4 * fq) = o;
        }
    } else {
        f32x4 d[8]; float ss = 0.f;
#pragma unroll
        for (int c = 0; c < 8; ++c) {
            d[c] = O[0][c] * inv[0] - a.lam * (O[NMAP - 1][c] * inv[NMAP - 1]);
            ss += d[c][0] * d[c][0] + d[c][1] * d[c][1] + d[c][2] * d[c][2] + d[c][3] * d[c][3];
        }
        ss += __shfl_xor(ss, 16); ss += __shfl_xor(ss, 32);
        const float rn = rsqrtf(ss * (1.0f / 128.0f) + 1e-6f) * a.oml;
#pragma unroll
        for (int c = 0; c < 8; ++c) {
            const f32x4 g = *(const f32x4*)(a.subg + 16 * c + 4 * fq);
            const f32x4 v = d[c] * rn * g;
            u32x2 o; o[0] = pack_bf2(v[0], v[1]); o[1] = pack_bf2(v[2], v[3]);
            *(u32x2*)(orow + 16 * c + 4 * fq) = o;
        }
    }
    __syncthreads();
}

__device__ __forceinline__ void sg_unit(const Params& p, int l, int chunk, int g, char* smem, int tid) {
    constexpr int TSTR = 272;
    char* vnT = smem;
    float* stat = (float*)(smem + 128 * TSTR);
    const int t = tid, lane = t & 63, wid = t >> 6, fr = lane & 15, fq = lane >> 4;
    const int row0 = chunk * 128;
    {
        const int tok = t >> 2, part = t & 3;
        const bf16_t* vp = p.P() + (size_t)(row0 + tok) * INW + C_V + part * 128;
        float s = 0.f, q = 0.f;
#pragma unroll
        for (int i = 0; i < 16; ++i) {
            const u32x4 w = *(const u32x4*)(vp + i * 8);
#pragma unroll
            for (int j = 0; j < 4; ++j) { const float a = bf_lo(w[j]), b = bf_hi(w[j]); s += a + b; q += a * a + b * b; }
        }
        s += __shfl_xor(s, 1); s += __shfl_xor(s, 2); q += __shfl_xor(q, 1); q += __shfl_xor(q, 2);
        const float mean = s * (1.0f / 512.0f);
        const float var = fmaxf(q * (1.0f / 512.0f) - mean * mean, 0.f);
        if (part == 0) { stat[tok * 2] = mean; stat[tok * 2 + 1] = rsqrtf(var + 1e-5f); }
    }
    __syncthreads();
    {
        const int q = t & 127, part = t >> 7;
        const float mean = stat[q * 2], rstd = stat[q * 2 + 1];
        const bf16_t* vp = p.P() + (size_t)(row0 + q) * INW + C_V + g * 128 + part * 32;
        const float* lg = p.vec() + V_SGLNG + (size_t)l * 512 + g * 128 + part * 32;
        const float* lb = p.vec() + V_SGLNB + (size_t)l * 512 + g * 128 + part * 32;
#pragma unroll
        for (int i = 0; i < 4; ++i) {
            const u32x4 w = *(const u32x4*)(vp + i * 8);
#pragma unroll
            for (int j = 0; j < 4; ++j) {
                const int c = part * 32 + i * 8 + 2 * j;
                const float a = (bf_lo(w[j]) - mean) * rstd * lg[i * 8 + 2 * j] + lb[i * 8 + 2 * j];
                const float b = (bf_hi(w[j]) - mean) * rstd * lg[i * 8 + 2 * j + 1] + lb[i * 8 + 2 * j + 1];
                const unsigned pk = pack_bf2(a, b);
                *(bf16_t*)(vnT + c * TSTR + q * 2) = (bf16_t)(pk & 0xffff);
                *(bf16_t*)(vnT + (c + 1) * TSTR + q * 2) = (bf16_t)(pk >> 16);
            }
        }
    }
    __syncthreads();
    {
        bf16x8 Af[4];
#pragma unroll
        for (int s = 0; s < 4; ++s) Af[s] = *(const bf16x8*)(vnT + (16 * wid + fr) * TSTR + (32 * s + 8 * fq) * 2);
        const bf16_t* ws = p.sgwB() + ((size_t)l * 4 + g) * 128 * 128;
#pragma unroll
        for (int pt = 0; pt < 8; ++pt) {
            f32x4 acc = (f32x4){0.f, 0.f, 0.f, 0.f};
#pragma unroll
            for (int s = 0; s < 4; ++s) {
                const bf16x8 bfr = *(const bf16x8*)(ws + (size_t)(16 * pt + fr) * 128 + 32 * s + 8 * fq);
                acc = __builtin_amdgcn_mfma_f32_16x16x32_bf16(Af[s], bfr, acc, 0, 0, 0);
            }
            const int pos = 16 * pt + fr, c = 16 * wid + 4 * fq;
            const float bias = p.vec()[V_SGB + ((size_t)l * 4 + g) * 128 + pos];
            const bf16_t* up = p.P() + (size_t)(row0 + pos) * INW + C_U + g * 128 + c;
            const u32x2 uw = *(const u32x2*)up;
            u32x2 o;
            o[0] = pack_bf2(bf_lo(uw[0]) * (acc[0] + bias), bf_hi(uw[0]) * (acc[1] + bias));
            o[1] = pack_bf2(bf_lo(uw[1]) * (acc[2] + bias), bf_hi(uw[1]) * (acc[3] + bias));
            *(u32x2*)(p.MIX() + (size_t)(row0 + pos) * D + 1024 + g * 128 + c) = o;
        }
    }
    __syncthreads();
}

__device__ __forceinline__ void phase_mixers(const Params& p0, int l, char* smem, int tid0) {
    constexpr int U_CL = 256, U_NA = 512, U_AC = 256, U_CC = 128, U_SG = 384;
#if PROBE_DUP >= 10
    constexpr int PLO = PROBE_DUP == 10 ? 0 : (PROBE_DUP == 11 ? U_CL : (PROBE_DUP == 12 ? U_CL + U_NA : U_CL + U_NA + U_AC + U_CC));
    constexpr int PHI = PROBE_DUP == 10 ? U_CL : (PROBE_DUP == 11 ? U_CL + U_NA : (PROBE_DUP == 12 ? U_CL + U_NA + U_AC + U_CC : U_CL + U_NA + U_AC + U_CC + U_SG));
#pragma unroll 1
    for (int rep = 0; rep < 2; ++rep)
    for (int u = (rep ? PLO : 0) + blockIdx.x; u < (rep ? PHI : U_CL + U_NA + U_AC + U_CC + U_SG); u += gridDim.x) {
#else
    for (int u = blockIdx.x; u < U_CL + U_NA + U_AC + U_CC + U_SG; u += gridDim.x) {
#endif
        Params p = p0; int tid = tid0; asm volatile("" : "+s"(p.ws), "+v"(tid));
        const int t = tid, grp = t >> 8, gtid = t & 255;
        char* glds = smem + grp * ATT_GROUP_LDS;
        const float lam = p.lam()[l], oml = 1.0f - lam_init_of(l);
        if (u >= U_CL + U_NA + U_AC + U_CC) { const int v = u - (U_CL + U_NA + U_AC + U_CC); sg_unit(p, l, v >> 2, v & 3, smem, tid); continue; }
        AttnArgs a;
        a.rpb = nullptr; a.r = 0; a.r0 = 0; a.lam = lam; a.oml = oml; a.subg = p.vec() + V_SUBG + (size_t)l * 128;
        a.q[1] = nullptr; a.k[0][1] = nullptr; a.k[1][0] = nullptr; a.k[1][1] = nullptr; a.v[1] = nullptr;
        a.ldk[1] = 0; a.ldv[1] = 0; a.nt[1] = 0; a.ldq = INW; a.ldk[0] = INW; a.ldv[0] = INW;
        if (u < U_CL || u >= U_CL + U_NA + U_AC) {
            const bool lat = u < U_CL;
            int b, h, qc; size_t rb;
            const int ux = ((u & 7) << 5) | (u >> 3);
            if (lat) { b = ux >> 7; h = (ux >> 5) & 3; qc = (ux & 31) * 2 + grp; rb = (size_t)NP + (size_t)b * 4096; }
            else { const int v = u - (U_CL + U_NA + U_AC); b = v >> 3; h = (v >> 1) & 3; qc = (v & 1) * 2 + grp; rb = (size_t)b * 256; }
            const bf16_t* Pb = p.P() + rb * INW;
            a.q[0] = Pb + (size_t)(qc * 64) * INW + C_Q1 + h * 64; a.q[1] = Pb + (size_t)(qc * 64) * INW + C_Q2 + h * 64;
            a.k[0][0] = Pb + C_K1 + h * 64; a.k[0][1] = Pb + C_K2 + h * 64; a.v[0] = Pb + C_VC + h * 128; a.nt[0] = lat ? 64 : 4;
            if (lat) {
                const size_t cb = ((size_t)(b * DEPTH + l) * 4 + h) * 256;
                a.k[1][0] = p.cdk1() + cb * 64; a.k[1][1] = p.cdk2() + cb * 64; a.v[1] = p.cdv() + cb * 128; a.ldk[1] = 64; a.ldv[1] = 128; a.nt[1] = 4;
            }
            a.o = p.MIX() + (rb + (size_t)qc * 64) * D + 1536 + h * 128;
            a.scale_l2 = 0.125f * LOG2E;
            attn_group<2, 64, false, true>(a, smem, gtid, t);
        } else if (u < U_CL + U_NA) {
            const int v0 = u - U_CL, v = ((v0 & 7) << 6) | ((v0 >> 8) << 5) | ((v0 & 255) >> 3);
            const int b = v >> 8, hp = (v >> 6) & 3, r = v & 63, h = hp * 2 + grp;
            int r0 = r - 4; r0 = r0 < 0 ? 0 : (r0 > 56 ? 56 : r0);
            const size_t rb = (size_t)NP + (size_t)b * 4096;
            const bf16_t* Pb = p.P() + rb * INW;
            a.q[0] = Pb + (size_t)(r * 64) * INW + C_QA + h * 128;
            a.k[0][0] = Pb + (size_t)(r0 * 64) * INW + C_KA + h * 128; a.v[0] = Pb + (size_t)(r0 * 64) * INW + C_VA + h * 128; a.nt[0] = 8;
            const size_t cb = ((size_t)(b * DEPTH + l) * 8 + h) * 256 * 128;
            a.k[1][0] = p.cnak() + cb; a.v[1] = p.cnav() + cb; a.ldk[1] = 128; a.ldv[1] = 128; a.nt[1] = 4;
            a.o = p.MIX() + (rb + (size_t)r * 64) * D + h * 128;
            a.scale_l2 = 0.08838834764831845f * LOG2E;
            a.rpb = p.vec() + V_RPB + ((size_t)l * 8 + h) * 465; a.r = r; a.r0 = r0;
            attn_group<1, 128, true, false>(a, glds, gtid, gtid);
        } else {
            const int v = u - U_CL - U_NA, b = v >> 4, h = (v >> 1) & 7, qc = (v & 1) * 2 + grp;
            const bf16_t* Pb = p.P() + (size_t)(b * 256) * INW;
            a.q[0] = Pb + (size_t)(qc * 64) * INW + C_QA + h * 128;
            a.k[0][0] = Pb + C_KA + h * 128; a.v[0] = Pb + C_VA + h * 128; a.nt[0] = 4;
            a.o = p.MIX() + (size_t)(b * 256 + qc * 64) * D + h * 128;
            a.scale_l2 = 0.08838834764831845f * LOG2E;
            attn_group<1, 128, false, true>(a, smem, gtid, t);
        }
    }
}

template <int CTRL> __device__ __forceinline__ int dpp_i(int v) { return __builtin_amdgcn_update_dpp(0, v, CTRL, 0xf, 0xf, true); }
__device__ __forceinline__ int imax(int a, int b) { return a > b ? a : b; }
__device__ __forceinline__ int f2ord(float f) { const int b = __float_as_int(f); return b ^ ((b >> 31) & 0x7fffffff); }
__device__ __forceinline__ float ord2f(int o) { return __int_as_float(o ^ ((o >> 31) & 0x7fffffff)); }

constexpr int PL_SCR1 = 16384, PL_LIST = 32768, PL_LIST_BYTES = 16384;

__device__ __forceinline__ void select_scores_topk(const Params& p, int l, int row0, int h, int ha, int hh_slot, float* tkv, int* tki, int fr, int fq) {
    bf16x8 Qf[4];
#pragma unroll
    for (int s = 0; s < 4; ++s) Qf[s] = *(const bf16x8*)(p.Qp() + (size_t)(row0 + fr) * D + h * 256 + ha * 128 + 32 * s + 8 * fq);
    const bf16_t* kb = p.keysB() + (((size_t)l * 8 + h) * 2 + ha) * 128 * 128;
    int pk[4][8];
#pragma unroll
    for (int nt = 0; nt < 8; ++nt) {
        f32x4 acc = (f32x4){0.f, 0.f, 0.f, 0.f};
#pragma unroll
        for (int s = 0; s < 4; ++s) {
            const bf16x8 kf = *(const bf16x8*)(kb + (size_t)(16 * nt + fr) * 128 + 32 * s + 8 * fq);
            acc = __builtin_amdgcn_mfma_f32_16x16x32_bf16(Qf[s], kf, acc, 0, 0, 0);
        }
#pragma unroll
        for (int j = 0; j < 4; ++j) pk[j][nt] = (f2ord(acc[j]) & ~127) | (127 - (16 * nt + fr));
    }
#pragma unroll 1
    for (int rd = 0; rd < 16; ++rd) {
#pragma unroll
        for (int j = 0; j < 4; ++j) {
            int m = imax(imax(imax(pk[j][0], pk[j][1]), imax(pk[j][2], pk[j][3])), imax(imax(pk[j][4], pk[j][5]), imax(pk[j][6], pk[j][7])));
            m = imax(m, dpp_i<0xB1>(m)); m = imax(m, dpp_i<0x4E>(m)); m = imax(m, dpp_i<0x141>(m)); m = imax(m, dpp_i<0x140>(m));
#pragma unroll
            for (int nt = 0; nt < 8; ++nt) pk[j][nt] = pk[j][nt] == m ? (int)0x80000000 : pk[j][nt];
            if (fr == 0) {
                const int tok = 4 * fq + j;
                tkv[((tok * 4 + hh_slot) * 2 + ha) * 16 + rd] = ord2f(m & ~127);
                tki[((tok * 4 + hh_slot) * 2 + ha) * 16 + rd] = 127 - (m & 127);
            }
        }
    }
}
__device__ __forceinline__ void staircase_cells(int sub, int (&cell)[7]) {
#pragma unroll
    for (int m = 0; m < 7; ++m) {
        const int n = sub + 8 * m;
        int i = 0, base = 0; bool go = true;
#pragma unroll
        for (int ii = 0; ii < 16; ++ii) { const int cnt = 16 / (ii + 1); go = go && (n >= base + cnt); if (go) { base += cnt; i = ii + 1; } }
        cell[m] = n < 50 ? i * 16 + (n - base) : -1;
    }
}
__device__ __forceinline__ void select_stage2(int tok, int h2, int sub, const int (&cell)[7], const float* tkv, const int* tki, int* idl, float* gl, int hq) {
    const float* v0 = tkv + ((tok * 4 + h2) * 2 + 0) * 16; const float* v1 = tkv + ((tok * 4 + h2) * 2 + 1) * 16;
    const int* i0 = tki + ((tok * 4 + h2) * 2 + 0) * 16;   const int* i1 = tki + ((tok * 4 + h2) * 2 + 1) * 16;
    int cp[7];
#pragma unroll
    for (int m = 0; m < 7; ++m) {
        const bool ok = cell[m] >= 0;
        const int c = ok ? cell[m] : 0;
        const float cv = v0[c >> 4] + v1[c & 15];
        cp[m] = ok ? ((f2ord(cv) & ~255) | (255 - c)) : (int)0x80000000;
    }
    int bidx[16];
#pragma unroll
    for (int rd = 0; rd < 16; ++rd) {
        int m = imax(imax(imax(cp[0], cp[1]), imax(cp[2], cp[3])), imax(imax(cp[4], cp[5]), cp[6]));
        m = imax(m, dpp_i<0xB1>(m)); m = imax(m, dpp_i<0x4E>(m)); m = imax(m, dpp_i<0x141>(m));
#pragma unroll
        for (int q = 0; q < 7; ++q) cp[q] = cp[q] == m ? (int)0x80000000 : cp[q];
        bidx[rd] = 255 - (m & 255);
    }
    if (sub == 0) {
        float best[16], e[16], sum = 0.f;
#pragma unroll
        for (int rd = 0; rd < 16; ++rd) best[rd] = v0[bidx[rd] >> 4] + v1[bidx[rd] & 15];
#pragma unroll
        for (int rd = 0; rd < 16; ++rd) { e[rd] = __expf(best[rd] - best[0]); sum += e[rd]; }
        const float inv = 1.0f / sum;
        const int ob = tok * 128 + (hq * 4 + h2) * 16;
#pragma unroll
        for (int rd = 0; rd < 16; ++rd) {
            const int c = bidx[rd];
            idl[ob + rd] = i0[c >> 4] * 128 + i1[c & 15];
            gl[ob + rd] = e[rd] * inv;
        }
    }
}
template <int NH>
__device__ __forceinline__ void select_wave(const Params& p, int l, char* scr, int lane, int tb, int hq, int hs0, char* list) {
    const int fr = lane & 15, fq = lane >> 4;
    float* tkv = (float*)scr; int* tki = (int*)(scr + 8192);
#pragma unroll 1
    for (int hw = 0; hw < 2 * NH; ++hw) select_scores_topk(p, l, tb * 16, hq * 4 + hs0 + (hw >> 1), hw & 1, hs0 + (hw >> 1), tkv, tki, fr, fq);
    asm volatile("s_waitcnt lgkmcnt(0)" ::: "memory");
    int cell[7]; staircase_cells(lane & 7, cell);
#pragma unroll 1
    for (int ps = 0; ps < 2 * NH; ++ps) {
        const int pr = ps * 8 + (lane >> 3);
        select_stage2(NH == 1 ? pr : pr >> 1, hs0 + (NH == 1 ? 0 : (pr & 1)), lane & 7, cell, tkv, tki, (int*)list, (float*)(list + 8192), hq);
    }
}

typedef int v8i_t __attribute__((ext_vector_type(8)));
constexpr int PW_SCR = 65536, PW_STRIDE = 5632;
__device__ __forceinline__ void apply_token(const Params& p, int l, int lane, int r, const int* idl, const int id0, const int id1, const float g0, const float g1, char* wscr) {
    const unsigned char* Ul = p.Ub() + (size_t)l * NEXP * ROW4;
    const unsigned char* Vl = p.Vb() + (size_t)l * NEXP * ROW4;
    {
        const int fr = lane & 15, fq = lane >> 4;
        {
            float rr[32];
#pragma unroll
            for (int v = 0; v < 4; ++v) {
                const u32x4 q = *(const u32x4*)(p.H() + (size_t)r * D + lane * 32 + 8 * v);
#pragma unroll
                for (int j = 0; j < 4; ++j) { rr[8 * v + 2 * j] = 0.25f * bf_lo(q[j]); rr[8 * v + 2 * j + 1] = 0.25f * bf_hi(q[j]); }
            }
#pragma unroll
            for (int lv = 0; lv < 4; ++lv) {
                u32x4 o;
#pragma unroll
                for (int w = 0; w < 4; ++w) {
                    unsigned pk = 0;
                    pk = __builtin_amdgcn_cvt_scalef32_pk_fp4_f32(pk, rr[8 * w], rr[8 * w + 1], 1.0f, 0);
                    pk = __builtin_amdgcn_cvt_scalef32_pk_fp4_f32(pk, rr[8 * w + 2], rr[8 * w + 3], 1.0f, 1);
                    pk = __builtin_amdgcn_cvt_scalef32_pk_fp4_f32(pk, rr[8 * w + 4], rr[8 * w + 5], 1.0f, 2);
                    pk = __builtin_amdgcn_cvt_scalef32_pk_fp4_f32(pk, rr[8 * w + 6], rr[8 * w + 7], 1.0f, 3);
                    o[w] = pk;
                    if (lv < 3) {
                        const f32x2 d0 = __builtin_amdgcn_cvt_scalef32_pk_f32_fp4(pk, 1.0f, 0), d1 = __builtin_amdgcn_cvt_scalef32_pk_f32_fp4(pk, 1.0f, 1);
                        const f32x2 d2 = __builtin_amdgcn_cvt_scalef32_pk_f32_fp4(pk, 1.0f, 2), d3 = __builtin_amdgcn_cvt_scalef32_pk_f32_fp4(pk, 1.0f, 3);
                        rr[8 * w] = 4.0f * (rr[8 * w] - d0[0]); rr[8 * w + 1] = 4.0f * (rr[8 * w + 1] - d0[1]);
                        rr[8 * w + 2] = 4.0f * (rr[8 * w + 2] - d1[0]); rr[8 * w + 3] = 4.0f * (rr[8 * w + 3] - d1[1]);
                        rr[8 * w + 4] = 4.0f * (rr[8 * w + 4] - d2[0]); rr[8 * w + 5] = 4.0f * (rr[8 * w + 5] - d2[1]);
                        rr[8 * w + 6] = 4.0f * (rr[8 * w + 6] - d3[0]); rr[8 * w + 7] = 4.0f * (rr[8 * w + 7] - d3[1]);
                    }
                }
                *(u32x4*)(wscr + lv * 1024 + lane * 16) = o;
            }
        }
        __builtin_amdgcn_wave_barrier();
        const unsigned char* rowp[8];
#pragma unroll
        for (int T = 0; T < 8; ++T) rowp[T] = Ul + (size_t)idl[T * 16 + fr] * ROW4 + fq * 16;
        const char* bsrc = wscr + (fr & 3) * 1024 + fq * 16;
        const int sa = 0x7F7F7F7F, sb = 0x7F7F7F7F;
        f32x4 acc[8];
#pragma unroll
        for (int T = 0; T < 8; ++T) acc[T] = (f32x4){0.f, 0.f, 0.f, 0.f};
        u32x4 A[3][4][2];
#pragma unroll
        for (int st = 0; st < 2; ++st)
#pragma unroll
            for (int tt = 0; tt < 4; ++tt)
#pragma unroll
                for (int kk = 0; kk < 2; ++kk) A[st][tt][kk] = *(const u32x4*)(rowp[4 * (st & 1) + tt] + (st >> 1) * 128 + kk * 64);
        v8i_t B[2];
        u32x4 VA[8][4];
        const unsigned char* vbase = Vl + fr * 16;
        const int* idp = idl + fq * 32;
        const u32x4 i0 = *(const u32x4*)idp, i1 = *(const u32x4*)(idp + 4);
#pragma unroll
        for (int st = 0; st < 16; ++st) {
            if (st == 14) {
#pragma unroll
                for (int vs = 0; vs < 4; ++vs)
#pragma unroll
                    for (int q = 0; q < 4; ++q) VA[vs][q] = *(const u32x4*)(vbase + (size_t)i0[vs] * ROW4 + q * 256);
            }
            if (st + 2 < 16) {
                const int s2 = st + 2;
#pragma unroll
                for (int tt = 0; tt < 4; ++tt)
#pragma unroll
                    for (int kk = 0; kk < 2; ++kk) A[s2 % 3][tt][kk] = *(const u32x4*)(rowp[4 * (s2 & 1) + tt] + (s2 >> 1) * 128 + kk * 64);
            }
            if ((st & 1) == 0) {
#pragma unroll
                for (int kk = 0; kk < 2; ++kk) {
                    const u32x4 b0 = *(const u32x4*)(bsrc + (st + kk) * 64);
                    B[kk] = (v8i_t){(int)b0[0], (int)b0[1], (int)b0[2], (int)b0[3], 0, 0, 0, 0};
                }
            }
            __builtin_amdgcn_sched_barrier(0);
#pragma unroll
            for (int tt = 0; tt < 4; ++tt)
#pragma unroll
                for (int kk = 0; kk < 2; ++kk) {
                    const u32x4 a = A[st % 3][tt][kk];
                    const v8i_t av = (v8i_t){(int)a[0], (int)a[1], (int)a[2], (int)a[3], 0, 0, 0, 0};
                    acc[4 * (st & 1) + tt] = __builtin_amdgcn_mfma_scale_f32_16x16x128_f8f6f4(av, B[kk], acc[4 * (st & 1) + tt], 4, 4, 0, sa, 0, sb);
                }
#pragma unroll
            for (int tt = 0; tt < 4; ++tt) asm volatile("" : "+v"(acc[4 * (st & 1) + tt]));
            __builtin_amdgcn_sched_barrier(0);
        }
#pragma unroll
        for (int vs = 4; vs < 7; ++vs)
#pragma unroll
            for (int q = 0; q < 4; ++q) VA[vs][q] = *(const u32x4*)(vbase + (size_t)i1[vs - 4] * ROW4 + q * 256);
        __builtin_amdgcn_sched_barrier(0);
        float* wdot = (float*)(wscr + 4096);
        const float lvs = ((fr & 3) == 0 ? 4.0f : (fr & 3) == 1 ? 1.0f : (fr & 3) == 2 ? 0.25f : 0.0625f) * (1.0f / U_SCALE);
#pragma unroll
        for (int T = 0; T < 8; ++T) {
            f32x4 tot;
#pragma unroll
            for (int j = 0; j < 4; ++j) {
                float t2 = acc[T][j] * lvs;
                t2 += __int_as_float(dpp_i<0xB1>(__float_as_int(t2)));
                t2 += __int_as_float(dpp_i<0x4E>(__float_as_int(t2)));
                tot[j] = t2;
            }
            if (fr == 0) *(f32x4*)(wdot + T * 16 + 4 * fq) = tot;
        }
        __builtin_amdgcn_wave_barrier();
        unsigned* wd = (unsigned*)(wscr + 4608);
        int sexp;
        {
            const float a0 = wdot[lane], a1 = wdot[64 + lane];
            const float w0 = g0 * (0.5f / V_SCALE) * a0 * (1.0f + erff(a0 * 0.70710678118654752f));
            const float w1 = g1 * (0.5f / V_SCALE) * a1 * (1.0f + erff(a1 * 0.70710678118654752f));
            float wm = fmaxf(fabsf(w0), fabsf(w1));
#pragma unroll
            for (int sft = 32; sft >= 1; sft >>= 1) wm = fmaxf(wm, __shfl_xor(wm, sft));
            int ex = (__float_as_int(wm) >> 23) & 0xFF;
            ex = ex < 28 ? 28 : ex;
            sexp = 128 - ex;
            const float S = __int_as_float((255 - ex) << 23);
#pragma unroll
            for (int hb = 0; hb < 2; ++hb) {
                const float r0 = (hb ? w1 : w0) * S;
                const unsigned e0 = __builtin_amdgcn_cvt_scalef32_pk_fp4_f32(0u, r0, 0.0f, 1.0f, 0) & 0xFFu;
                const unsigned o0 = __builtin_amdgcn_cvt_scalef32_pk_fp4_f32(0u, 0.0f, r0, 1.0f, 0) & 0xFFu;
                const f32x2 d0 = __builtin_amdgcn_cvt_scalef32_pk_f32_fp4(e0, 1.0f, 0);
                const float r1 = 4.0f * (r0 - d0[0]);
                const unsigned e1 = __builtin_amdgcn_cvt_scalef32_pk_fp4_f32(0u, r1, 0.0f, 1.0f, 0) & 0xFFu;
                const unsigned o1 = __builtin_amdgcn_cvt_scalef32_pk_fp4_f32(0u, 0.0f, r1, 1.0f, 0) & 0xFFu;
                wd[hb * 64 + lane] = e0 | (e1 << 8);
                wd[128 + hb * 64 + lane] = o0 | (o1 << 8);
            }
        }
        __builtin_amdgcn_wave_barrier();
        const int vsa = 127 * 0x01010101;
        const int vsb0 = (int)((unsigned)(127 - sexp) * 0x01010101u), vsb1 = (int)((unsigned)(127 - 2 - sexp) * 0x01010101u);
        const int bsh = 8 * ((fr >> 1) & 3);
        const bool blo = fr < 8;
        const unsigned* wdp = wd + (fr & 1) * 128 + fq * 32;
        f32x4 ya[8];
#pragma unroll
        for (int c = 0; c < 8; ++c) ya[c] = (f32x4){0.f, 0.f, 0.f, 0.f};
        {
            int idn = (int)i1[3];
#pragma unroll 1
            for (int G0 = 0; G0 < 32; G0 += 8) {
                const u32x4 xsA = *(const u32x4*)(wdp + G0), xsB = *(const u32x4*)(wdp + G0 + 4);
#pragma unroll
                for (int st = 0; st < 8; ++st) {
                    if (G0 + st + 7 < 32) {
#pragma unroll
                        for (int q = 0; q < 4; ++q) VA[(st + 7) & 7][q] = *(const u32x4*)(vbase + (size_t)idn * ROW4 + q * 256);
                    }
                    idn = idp[(G0 + st + 8) & 31];
                    __builtin_amdgcn_sched_barrier(0);
                    const unsigned xw = st < 4 ? xsA[st & 3] : xsB[st & 3];
#pragma unroll
                    for (int dg = 0; dg < 2; ++dg) {
                        const unsigned val = ((xw >> (8 * dg)) & 0xFFu) << bsh;
                        const int c0 = blo ? (int)val : 0, c1 = blo ? 0 : (int)val;
                        const v8i_t B0 = (v8i_t){c0, c1, 0, 0, 0, 0, 0, 0}, B1 = (v8i_t){0, 0, c0, c1, 0, 0, 0, 0};
#pragma unroll
                        for (int q = 0; q < 4; ++q) {
                            const u32x4 a = VA[st][q];
                            const v8i_t av = (v8i_t){(int)a[0], (int)a[1], (int)a[2], (int)a[3], 0, 0, 0, 0};
                            ya[2 * q] = __builtin_amdgcn_mfma_scale_f32_16x16x128_f8f6f4(av, B0, ya[2 * q], 4, 4, 0, vsa, 0, dg ? vsb1 : vsb0);
                            ya[2 * q + 1] = __builtin_amdgcn_mfma_scale_f32_16x16x128_f8f6f4(av, B1, ya[2 * q + 1], 4, 4, 0, vsa, 0, dg ? vsb1 : vsb0);
                        }
                    }
#pragma unroll
                    for (int c = 0; c < 8; ++c) asm volatile("" : "+v"(ya[c]));
                    __builtin_amdgcn_sched_barrier(0);
                }
            }
        }
        const int cnd = cond_of_row(r);
        const bool last = (l == DEPTH - 1);
        float* xo = last ? (r < NP ? p.outp() + O_YP + (size_t)r * D : p.outp() + O_YS + (size_t)(r - NP) * D) : p.X() + (size_t)r * D;
        const int ln = last ? l : l + 1;
        ln_row_finish_q(p, r, lane, p.X() + (size_t)r * D, ya, mod_ptr(p, l, cnd, 5), p.vec() + V_LNG + (size_t)(l * 2 + 1) * D, p.vec() + V_LNB + (size_t)(l * 2 + 1) * D,
                        xo, !last, mod_ptr(p, ln, cnd, 1), mod_ptr(p, ln, cnd, 0));
    }
}

__device__ __forceinline__ void phase_peer(const Params& p, int l, char* smem, int tid) {
    const int lane = tid & 63, wid = tid >> 6;
    const int nblk = NT / 16, G = gridDim.x;
    int tb = blockIdx.x;
    if (tb >= nblk) return;
    {
        Params ps = p; int ls = lane; asm volatile("" : "+s"(ps.ws), "+v"(ls));
        select_wave<1>(ps, l, smem + (wid >> 2) * PL_SCR1, ls, tb, wid >> 2, wid & 3, smem + PL_LIST);
        __syncthreads();
    }
    int cur = 0;
    for (; tb < nblk; tb += G, cur ^= 1) {
        const bool has_next = tb + G < nblk;
        char* list = smem + PL_LIST + cur * PL_LIST_BYTES;
        if (has_next && wid >= 4) {
            Params ps = p; int ls = lane; asm volatile("" : "+s"(ps.ws), "+v"(ls));
            select_wave<2>(ps, l, smem + ((wid - 4) >> 1) * PL_SCR1, ls, tb + G, (wid - 4) >> 1, ((wid - 4) & 1) * 2, smem + PL_LIST + (cur ^ 1) * PL_LIST_BYTES);
#if PROBE_DUP == 32
            select_wave<2>(ps, l, smem + ((wid - 4) >> 1) * PL_SCR1, ls, tb + G, (wid - 4) >> 1, ((wid - 4) & 1) * 2, smem + PL_LIST + (cur ^ 1) * PL_LIST_BYTES);
#endif
        } else {
            const int ngw = has_next ? 4 : 8;
            const int* idl = (const int*)list; const float* gl = (const float*)(list + 8192);
#pragma unroll 1
            for (int tl = wid; tl < 16; tl += ngw) {
                Params pa = p; int la = lane; asm volatile("" : "+s"(pa.ws), "+v"(la));
                const int id0 = idl[tl * 128 + la], id1 = idl[tl * 128 + 64 + la];
                const float g0 = gl[tl * 128 + la], g1 = gl[tl * 128 + 64 + la];
                apply_token(pa, l, la, tb * 16 + tl, idl + tl * 128, id0, id1, g0, g1, smem + PW_SCR + wid * PW_STRIDE);
            }
        }
        __syncthreads();
    }
}

__device__ __forceinline__ void tail_convert(const Params& p, const Inputs& in, int l, int ntiles, int c0, int c1, int tid) {
    if (l + 1 >= DEPTH) return;
    const int G = gridDim.x, first = ntiles % G;
    int rank = -1, n = 0;
    if (first == 0) { rank = blockIdx.x; n = G; } else if ((int)blockIdx.x >= first) { rank = blockIdx.x - first; n = G - first; }
    if (rank < 0) return;
    const int nU = NEXP * D / 16384;
    const size_t lo = (size_t)(l + 1) * nU;
    for (int c = c0 + rank; c < c1; c += n) {
        if (c < nU) conv_chunk_fp4(in.pk_u, p.Ub(), lo + c, tid, U_SCALE);
        else conv_chunk_fp4v(in.pk_v, p.Vb(), lo + c - nU, tid, V_SCALE);
    }
}
__device__ __forceinline__ void phase_gemm1(const Params& p, const Inputs& in, int l, char* smem, int tid) {
    EpiProj e; e.pp = &p; e.l = l;
    gemm_phase(p.H(), p.WinT() + (size_t)l * INW * D, NT, INW, smem, e, tid);
    tail_convert(p, in, l, (NT / BM) * (INW / BM), 0, 1843, tid);
}
__device__ __forceinline__ void phase_gemm3(const Params& p, const Inputs& in, int l, char* smem, int tid) {
    EpiBf16 e; e.C = p.Y(); e.ldc = D;
    gemm_phase(p.MIX(), p.WoutT() + (size_t)l * D * D, NT, D, smem, e, tid);
    tail_convert(p, in, l, (NT / BM) * (D / BM), 1843, 2970, tid);
}
__device__ __forceinline__ void phase_gemm2(const Params& p, const Inputs& in, int l, char* smem, int tid) {
    EpiBf16 e; e.C = p.Qp(); e.ldc = D;
    gemm_phase(p.H(), p.WqT() + (size_t)l * D * D, NT, D, smem, e, tid);
    tail_convert(p, in, l, (NT / BM) * (D / BM), 2970, 4096, tid);
}

#define PHASE_ENTER Params q = p; int wv_ = wave_s; asm volatile("" : "+s"(q.ws), "+s"(q.out_g), "+s"(wv_)); int tid = (wv_ << 6) | lane_id(); asm volatile("" : "+v"(tid))
template <int PH>
__global__ void __launch_bounds__(512, 2) phase_kernel(Params p, Inputs in, int l) {
    extern __shared__ __attribute__((aligned(16))) char smem[];
    const int wave_s = __builtin_amdgcn_readfirstlane((int)(threadIdx.x >> 6));
    PHASE_ENTER;
    if (PH == 0) phase_prologue0(q, in, smem, tid);
    if (PH == 1) phase_prologue1(q, in, tid);
    if (PH == 2) phase_gemm1(q, in, l, smem, tid);
    if (PH == 3) phase_mixers(q, l, smem, tid);
    if (PH == 4) phase_gemm3(q, in, l, smem, tid);
    if (PH == 5) phase_ln1(q, l, tid);
    if (PH == 6) phase_gemm2(q, in, l, smem, tid);
    if (PH == 7) phase_peer(q, l, smem, tid);
}

#if MEGA
__global__ void __launch_bounds__(512, 2) mega_kernel(Params p, Inputs in) {
    extern __shared__ __attribute__((aligned(16))) char smem[];
    volatile LAS unsigned* st = (volatile LAS unsigned*)(smem + LDS_BAR_OFF);
    const int wave_s = __builtin_amdgcn_readfirstlane((int)(threadIdx.x >> 6));
    if (threadIdx.x == 0) { st[0] = 0u; st[1] = 0u; st[2] = 0u; st[3] = 0u; }
    __syncthreads();
    XcdBarrier bar = xcd_barrier_post(p.bar(), st);
    { PHASE_ENTER; phase_prologue0(q, in, smem, tid); } xcd_barrier(bar, wave_s);
#if PROBE_DUP == 6
    { PHASE_ENTER; phase_prologue0(q, in, smem, tid); } xcd_barrier(bar, wave_s);
#endif
    { PHASE_ENTER; phase_prologue1(q, in, tid); } xcd_barrier(bar, wave_s);
    for (int l = 0; l < DEPTH; ++l) {
        { PHASE_ENTER; phase_gemm1(q, in, l, smem, tid); } xcd_barrier(bar, wave_s);
#if PROBE_DUP == 3
        { PHASE_ENTER; phase_gemm1(q, in, l, smem, tid); } xcd_barrier(bar, wave_s);
#endif
        { PHASE_ENTER; phase_mixers(q, l, smem, tid); } xcd_barrier(bar, wave_s);
#if PROBE_DUP == 2
        { PHASE_ENTER; phase_mixers(q, l, smem, tid); } xcd_barrier(bar, wave_s);
#endif
        { PHASE_ENTER; phase_gemm3(q, in, l, smem, tid); } xcd_barrier(bar, wave_s);
#if PROBE_DUP == 4
        { PHASE_ENTER; phase_gemm3(q, in, l, smem, tid); } xcd_barrier(bar, wave_s);
#endif
        { PHASE_ENTER; phase_ln1(q, l, tid); } xcd_barrier(bar, wave_s);
        { PHASE_ENTER; phase_gemm2(q, in, l, smem, tid); } xcd_barrier(bar, wave_s);
        { PHASE_ENTER; phase_peer(q, l, smem, tid); } xcd_barrier(bar, wave_s);
    }
}
#endif

extern "C" void kernel_launch(void* const* d_in, const int* in_sizes, int n_in, void* d_out, int out_size, void* d_ws, size_t ws_size, hipStream_t stream) {
    (void)in_sizes; (void)n_in; (void)out_size;
    Params p{}; Inputs in{};
    const float* const* di = (const float* const*)d_in;
    in.x_prompt = di[0]; in.x_sample = di[1]; in.c_na_k = di[2]; in.c_na_v = di[3]; in.c_df_k1 = di[4]; in.c_df_k2 = di[5]; in.c_df_v = di[6];
    in.c = di[7]; in.c_ctx = di[8]; in.w_mod = di[9]; in.b_mod = di[10]; in.w_in = di[11]; in.na_rpb = di[12]; in.sg_ln_g = di[13]; in.sg_ln_b = di[14];
    in.sg_w = di[15]; in.sg_b = di[16]; in.df_lambda = di[17]; in.df_subln_g = di[18]; in.w_out = di[19]; in.pk_wq = di[20]; in.pk_keys = di[21];
    in.pk_u = di[22]; in.pk_v = di[23]; in.ln_g = di[24]; in.ln_b = di[25];
    p.ws = (GAS char*)d_ws; p.out_g = (GAS float*)d_out;
    if (ws_size < W_END) { fprintf(stderr, "workspace too small: %zu < %zu\n", ws_size, (size_t)W_END); return; }

    static int grid = 0;
    if (!grid) {
        int dev = 0, cus = 0;
        (void)hipGetDevice(&dev);
        (void)hipDeviceGetAttribute(&cus, hipDeviceAttributeMultiprocessorCount, dev);
        if (cus <= 0) cus = 256;
        grid = cus;
#if MEGA
        (void)hipFuncSetAttribute((const void*)mega_kernel, hipFuncAttributeMaxDynamicSharedMemorySize, LDS_BYTES);
        int per_cu = 0;
        (void)hipOccupancyMaxActiveBlocksPerMultiprocessor(&per_cu, (const void*)mega_kernel, 512, LDS_BYTES);
        if (per_cu < 1) fprintf(stderr, "mega_kernel: occupancy query says %d blocks per CU\n", per_cu);
#else
        (void)hipFuncSetAttribute((const void*)phase_kernel<0>, hipFuncAttributeMaxDynamicSharedMemorySize, LDS_BYTES);
        (void)hipFuncSetAttribute((const void*)phase_kernel<2>, hipFuncAttributeMaxDynamicSharedMemorySize, LDS_BYTES);
        (void)hipFuncSetAttribute((const void*)phase_kernel<3>, hipFuncAttributeMaxDynamicSharedMemorySize, LDS_BYTES);
        (void)hipFuncSetAttribute((const void*)phase_kernel<4>, hipFuncAttributeMaxDynamicSharedMemorySize, LDS_BYTES);
        (void)hipFuncSetAttribute((const void*)phase_kernel<6>, hipFuncAttributeMaxDynamicSharedMemorySize, LDS_BYTES);
        (void)hipFuncSetAttribute((const void*)phase_kernel<7>, hipFuncAttributeMaxDynamicSharedMemorySize, LDS_BYTES);
#endif
    }
#if MEGA
    (void)hipMemsetAsync((char*)d_ws + W_BAR, 0, XCD_BAR_WORDS * 4, stream);
    mega_kernel<<<grid, 512, LDS_BYTES, stream>>>(p, in);
#else
    phase_kernel<0><<<grid, 512, LDS_BYTES, stream>>>(p, in, 0);
    phase_kernel<1><<<grid, 512, 0, stream>>>(p, in, 0);
    for (int l = 0; l < DEPTH; ++l) {
        phase_kernel<2><<<grid, 512, LDS_BYTES, stream>>>(p, in, l);
        phase_kernel<3><<<grid, 512, LDS_BYTES, stream>>>(p, in, l);
        phase_kernel<4><<<grid, 512, LDS_BYTES, stream>>>(p, in, l);
        phase_kernel<5><<<grid, 512, 0, stream>>>(p, in, l);
        phase_kernel<6><<<grid, 512, LDS_BYTES, stream>>>(p, in, l);
        phase_kernel<7><<<grid, 512, LDS_BYTES, stream>>>(p, in, l);
    }
#endif
}
```
